# Optimizing an MI355X kernel written in HIP

```python
import jax, jax.numpy as jnp
from jax import lax
import numpy as np

D_MODEL = 1024
BATCH = 32
SEQ = 256
DEPTH = 4
DEC_BATCH = 2
DEC_SEQ = 2048
PAST_LEN = 256

GRID_W = 64
N_MIXERS = 3
N_FNET_LAYERS = (DEPTH + 2) // N_MIXERS
N_POOL_LAYERS = (DEPTH + 1) // N_MIXERS
N_MLA_LAYERS = DEPTH // N_MIXERS
N_FOURIER_GROUPS = 4
FOURIER_GROUP = D_MODEL // N_FOURIER_GROUPS
POOL_WINDOWS = (2, 4, 8, 16)
N_POOL_GROUPS = len(POOL_WINDOWS)
POOL_GROUP = D_MODEL // N_POOL_GROUPS
N_HEADS = 8
QK_NOPE = 128
QK_ROPE = 64
V_HEAD = 128
Q_RANK = 768
KV_RANK = 512
ROPE_AXIS = QK_ROPE // 2
ROPE_BASE = 10000.0
Q_BLOCK = 128
SM_SCALE = (QK_NOPE + QK_ROPE) ** -0.5
D_FF = 2816
CONV_W = 3
N_MOD = 6
EPS = 1e-6

kernel_name = 'hybrid_fnet_pool_mla_diffusion_step'


def rms_norm(x):
    xf = x.astype(jnp.float32)
    y = xf * lax.rsqrt(jnp.mean(xf * xf, axis=-1, keepdims=True) + EPS)
    return y.astype(x.dtype)


def rms_norm_gain(x, g):
    return rms_norm(x) * g


def ada_mod(cond, w, b):
    mod = jax.nn.silu(cond) @ w + b
    return tuple(m[:, None, :] for m in jnp.split(mod, N_MOD, axis=-1))


def modulate(x, shift, scale):
    return rms_norm(x) * (1 + scale) + shift


def fourier_mix(h, w_out):
    B, T, D = h.shape
    hg = h.astype(jnp.float32).reshape(B, T, N_FOURIER_GROUPS, FOURIER_GROUP)
    f = jnp.fft.fftn(hg, axes=(1, 3), norm='ortho').real
    return f.astype(h.dtype).reshape(B, T, D) @ w_out


def pool_mix(h, w_pool, scale):
    B, T, D = h.shape
    hg = h.astype(jnp.float32).reshape(B, T, N_POOL_GROUPS, POOL_GROUP)
    cs = jnp.concatenate([jnp.zeros((B, 1, N_POOL_GROUPS, POOL_GROUP), jnp.float32),
                          jnp.cumsum(hg, axis=1)], axis=1)
    t = jnp.arange(T)
    outs = []
    for g, w in enumerate(POOL_WINDOWS):
        lo = jnp.clip(t - w // 2, 0, T)
        hi = jnp.clip(t - w // 2 + w, 0, T)
        s = cs[:, hi, g] - cs[:, lo, g]
        cnt = (hi - lo).astype(jnp.float32)[None, :, None]
        outs.append(s / cnt - hg[:, :, g])
    pooled = jnp.stack(outs, axis=2).astype(h.dtype)
    y = jnp.einsum('btgc,gcd->btgd', pooled, w_pool).reshape(B, T, D)
    return y * scale


def dwconv3(u, w, b):
    up = jnp.pad(u, ((0, 0), (1, 1), (0, 0)))
    return up[:, :-2] * w[0] + up[:, 1:-1] * w[1] + up[:, 2:] * w[2] + b


def conv_ffn(h, w_in, w_conv, b_conv, w_out):
    u = dwconv3(h @ w_in, w_conv, b_conv)
    gate, val = jnp.split(u, 2, axis=-1)
    return (jax.nn.silu(gate) * val) @ w_out


def axial_rope_tables(n_tok):
    rows = n_tok // GRID_W
    row = jnp.repeat(jnp.arange(rows), GRID_W).astype(jnp.float32)
    col = jnp.tile(jnp.arange(GRID_W), rows).astype(jnp.float32)
    inv = 1.0 / (ROPE_BASE ** (jnp.arange(0, ROPE_AXIS, 2, dtype=jnp.float32) / ROPE_AXIS))
    ang_r = (row[:, None] * inv)[:, None, :]
    ang_c = (col[:, None] * inv)[:, None, :]
    return (jnp.cos(ang_r), jnp.sin(ang_r), jnp.cos(ang_c), jnp.sin(ang_c))


def rotate_half(x, cos, sin):
    x1, x2 = jnp.split(x, 2, axis=-1)
    cos = cos.astype(x.dtype)
    sin = sin.astype(x.dtype)
    return jnp.concatenate([x1 * cos - x2 * sin, x2 * cos + x1 * sin], axis=-1)


def apply_axial_rope(x, tabs):
    cos_r, sin_r, cos_c, sin_c = tabs
    xr, xc = jnp.split(x, 2, axis=-1)
    return jnp.concatenate([rotate_half(xr, cos_r, sin_r), rotate_half(xc, cos_c, sin_c)], axis=-1)


def mla_project(h, w_dq, g_q, w_uq, w_dkv, g_kv):
    B, T, _ = h.shape
    cq = rms_norm_gain(h @ w_dq, g_q)
    q = (cq @ w_uq).reshape(B, T, N_HEADS, QK_NOPE + QK_ROPE)
    ckv = h @ w_dkv
    c_kv = rms_norm_gain(ckv[..., :KV_RANK], g_kv)
    k_pe = ckv[..., KV_RANK:]
    return q[..., :QK_NOPE], q[..., QK_NOPE:], c_kv, k_pe


def mla_expand(c_kv, w_ukv):
    B, T, _ = c_kv.shape
    kv = (c_kv @ w_ukv).reshape(B, T, N_HEADS, QK_NOPE + V_HEAD)
    return kv[..., :QK_NOPE], kv[..., QK_NOPE:]


def mla_attend(q_nope, q_pe, k_nope, k_pe, v):
    B, Tq = q_nope.shape[:2]
    nb = Tq // Q_BLOCK
    qn = q_nope.reshape(B, nb, Q_BLOCK, N_HEADS, QK_NOPE).transpose(1, 0, 2, 3, 4)
    qp = q_pe.reshape(B, nb, Q_BLOCK, N_HEADS, QK_ROPE).transpose(1, 0, 2, 3, 4)

    def block(args):
        qn_b, qp_b = args
        s = (jnp.einsum('bqhd,bkhd->bhqk', qn_b, k_nope)
             + jnp.einsum('bqhr,bkr->bhqk', qp_b, k_pe))
        p = jax.nn.softmax(s.astype(jnp.float32) * SM_SCALE, axis=-1).astype(v.dtype)
        return jnp.einsum('bhqk,bkhd->bqhd', p, v)

    o = lax.map(block, (qn, qp))
    return o.transpose(1, 0, 2, 3, 4).reshape(B, Tq, N_HEADS * V_HEAD)


def mla_context(h, w_dq, g_q, w_uq, w_dkv, g_kv, w_ukv, w_o):
    q_nope, q_pe, c_kv, k_pe = mla_project(h, w_dq, g_q, w_uq, w_dkv, g_kv)
    k_nope, v = mla_expand(c_kv, w_ukv)
    out = mla_attend(q_nope, q_pe, k_nope, k_pe, v) @ w_o
    return out, c_kv, k_pe


def mla_latent(h, ctx_ckv, ctx_kpe, tabs, w_dq, g_q, w_uq, w_dkv, g_kv, w_ukv, w_o):
    q_nope, q_pe, c_kv, k_pe = mla_project(h, w_dq, g_q, w_uq, w_dkv, g_kv)
    q_pe = apply_axial_rope(q_pe, tabs)
    k_pe = apply_axial_rope(k_pe[:, :, None, :], tabs)[:, :, 0, :]
    c_all = jnp.concatenate([ctx_ckv.astype(c_kv.dtype), c_kv], axis=1)
    kpe_all = jnp.concatenate([ctx_kpe.astype(k_pe.dtype), k_pe], axis=1)
    k_nope, v = mla_expand(c_all, w_ukv)
    return mla_attend(q_nope, q_pe, k_nope, kpe_all, v) @ w_o


def setup_inputs(seed: int = 0) -> dict:
    key = jax.random.key(seed)
    ks = jax.random.split(key, 24)

    def nrm(k, shape, scale):
        return jax.random.normal(k, shape, jnp.float32) * scale

    D = D_MODEL
    return {
        'x_prompt': nrm(ks[0], (BATCH, SEQ, D), 1.0),
        'x_sample': nrm(ks[1], (DEC_BATCH, DEC_SEQ, D), 1.0),
        'cache_ckv': nrm(ks[2], (DEC_BATCH, N_MLA_LAYERS, PAST_LEN, KV_RANK), 1.0),
        'cache_kpe': nrm(ks[3], (DEC_BATCH, N_MLA_LAYERS, PAST_LEN, QK_ROPE), 1.0),
        'c': nrm(ks[4], (DEC_BATCH, D), 1.0),
        'c_ctx': nrm(ks[5], (D,), 1.0),
        'w_ada': nrm(ks[6], (DEPTH, D, N_MOD * D), D ** -0.5),
        'b_ada': nrm(ks[7], (DEPTH, N_MOD * D), 0.02),
        'w_fnet': nrm(ks[8], (N_FNET_LAYERS, D, D), D ** -0.5),
        'w_pool': nrm(ks[9], (N_POOL_LAYERS, N_POOL_GROUPS, POOL_GROUP, POOL_GROUP), POOL_GROUP ** -0.5),
        'pool_scale': 1.0 + nrm(ks[10], (N_POOL_LAYERS, D), 0.1),
        'w_dq': nrm(ks[11], (N_MLA_LAYERS, D, Q_RANK), D ** -0.5),
        'g_q': 1.0 + nrm(ks[12], (N_MLA_LAYERS, Q_RANK), 0.1),
        'w_uq': nrm(ks[13], (N_MLA_LAYERS, Q_RANK, N_HEADS * (QK_NOPE + QK_ROPE)), Q_RANK ** -0.5),
        'w_dkv': nrm(ks[14], (N_MLA_LAYERS, D, KV_RANK + QK_ROPE), D ** -0.5),
        'g_kv': 1.0 + nrm(ks[15], (N_MLA_LAYERS, KV_RANK), 0.1),
        'w_ukv': nrm(ks[16], (N_MLA_LAYERS, KV_RANK, N_HEADS * (QK_NOPE + V_HEAD)), KV_RANK ** -0.5),
        'w_o': nrm(ks[17], (N_MLA_LAYERS, N_HEADS * V_HEAD, D), (N_HEADS * V_HEAD) ** -0.5),
        'w_ffn_in': nrm(ks[18], (DEPTH, D, 2 * D_FF), D ** -0.5),
        'w_ffn_conv': nrm(ks[19], (DEPTH, CONV_W, 2 * D_FF), CONV_W ** -0.5),
        'b_ffn_conv': nrm(ks[20], (DEPTH, 2 * D_FF), 0.02),
        'w_ffn_out': nrm(ks[21], (DEPTH, D_FF, D), D_FF ** -0.5),
        'g_final': 1.0 + nrm(ks[22], (D,), 0.1),
    }


def reference(x_prompt, x_sample, cache_ckv, cache_kpe, c, c_ctx, w_ada, b_ada, w_fnet,
              w_pool, pool_scale, w_dq, g_q, w_uq, w_dkv, g_kv, w_ukv, w_o,
              w_ffn_in, w_ffn_conv, b_ffn_conv, w_ffn_out, g_final):
    lat_rope = axial_rope_tables(x_sample.shape[1])
    xp, xs = x_prompt, x_sample
    new_ckv, new_kpe = [], []
    j_f = 0
    j_p = 0
    j_a = 0
    for i in range(DEPTH):
        sh1p, sc1p, g1p, sh2p, sc2p, g2p = ada_mod(c_ctx[None, :], w_ada[i], b_ada[i])
        sh1s, sc1s, g1s, sh2s, sc2s, g2s = ada_mod(c, w_ada[i], b_ada[i])
        hp = modulate(xp, sh1p, sc1p)
        hs = modulate(xs, sh1s, sc1s)
        kind = i % N_MIXERS
        if kind == 0:
            mp = fourier_mix(hp, w_fnet[j_f])
            ms = fourier_mix(hs, w_fnet[j_f])
            j_f += 1
        elif kind == 1:
            mp = pool_mix(hp, w_pool[j_p], pool_scale[j_p])
            ms = pool_mix(hs, w_pool[j_p], pool_scale[j_p])
            j_p += 1
        else:
            prm = (w_dq[j_a], g_q[j_a], w_uq[j_a], w_dkv[j_a], g_kv[j_a], w_ukv[j_a], w_o[j_a])
            mp, ckv_p, kpe_p = mla_context(hp, *prm)
            ms = mla_latent(hs, cache_ckv[:, j_a], cache_kpe[:, j_a], lat_rope, *prm)
            new_ckv.append(ckv_p)
            new_kpe.append(kpe_p)
            j_a += 1
        xp = xp + g1p * mp
        xs = xs + g1s * ms
        xp = xp + g2p * conv_ffn(modulate(xp, sh2p, sc2p), w_ffn_in[i], w_ffn_conv[i],
                                 b_ffn_conv[i], w_ffn_out[i])
        xs = xs + g2s * conv_ffn(modulate(xs, sh2s, sc2s), w_ffn_in[i], w_ffn_conv[i],
                                 b_ffn_conv[i], w_ffn_out[i])
    y_prompt = rms_norm_gain(xp, g_final)
    y_sample = rms_norm_gain(xs, g_final)
    state_ckv = jnp.stack(new_ckv, axis=1)
    state_kpe = jnp.stack(new_kpe, axis=1)
    return (y_prompt, y_sample, state_ckv, state_kpe)
```

```cpp
#include <hip/hip_runtime.h>
#include <cstdio>
#include <cstdint>

#ifndef MK_PER_PHASE
#define MK_PER_PHASE 1
#endif

#define LAS __attribute__((address_space(3)))
#define GAS __attribute__((address_space(1)))
typedef unsigned short bf16_t;
typedef short bf16x8 __attribute__((ext_vector_type(8)));
typedef short s16x4 __attribute__((ext_vector_type(4)));
typedef float f32x4 __attribute__((ext_vector_type(4)));
typedef float f32x2 __attribute__((ext_vector_type(2)));
typedef float f32x16 __attribute__((ext_vector_type(16)));
typedef unsigned u32x4 __attribute__((ext_vector_type(4)));
typedef unsigned u32x2 __attribute__((ext_vector_type(2)));

constexpr int DM = 1024, NPB = 32, PSEQ = 256, NSB = 2, SSEQ = 2048, PAST = 256;
constexpr int NP = NPB * PSEQ;
constexpr int NS = NSB * SSEQ;
constexpr int NTOK = NP + NS;
constexpr int DFF = 2816, DFF2 = 5632;
constexpr int QRANK = 768, KVRANK = 512, ROPE = 64, NHEAD = 8, QKD = 192, VD = 128;
constexpr int NDOWN = 1536;
constexpr int KVROWS = NP + NSB * (PAST + SSEQ);
constexpr int SKV = PAST + SSEQ;
constexpr float EPS = 1e-6f;
constexpr float SM_SCALE = 0.07216878364870322f;

constexpr size_t MiB = 1u << 20;
constexpr size_t WS_CTL = 0, CTL_ZERO_BYTES = 1 * MiB;
constexpr size_t WS_X = 1 * MiB;
constexpr size_t WS_H = 49 * MiB;
constexpr size_t WS_WIN = 74 * MiB;
constexpr size_t WS_WOUT = 118 * MiB;
constexpr size_t WS_WFT = 140 * MiB;
constexpr size_t WS_WCS = 144 * MiB;
constexpr size_t WS_DFTS = 152 * MiB;
constexpr size_t WS_DFTP = 168 * MiB;
constexpr size_t WS_WPT = 169 * MiB;
constexpr size_t WS_WDT = 170 * MiB;
constexpr size_t WS_WUQT = 173 * MiB;
constexpr size_t WS_WUKVT = 176 * MiB;
constexpr size_t WS_WOT = 178 * MiB;
constexpr size_t WS_C256 = 180 * MiB;
constexpr size_t WS_S = 182 * MiB;
constexpr size_t WS_END = 372 * MiB;
constexpr size_t S_G = WS_S;
constexpr size_t S_ZF = WS_S;
constexpr size_t S_PL = WS_S;
constexpr size_t S_RAW = WS_S;
constexpr size_t S_QF = WS_S;
constexpr size_t S_KF = WS_S + 72 * MiB;
constexpr size_t S_CQ = WS_S + 110 * MiB;
constexpr size_t S_CALL = WS_S + 128 * MiB;
constexpr size_t S_VF = WS_S + 141 * MiB;
constexpr size_t S_O = WS_S + 166 * MiB;
constexpr int CW_BAR = 4096;
constexpr size_t CTL_MOD_OFF = 64 * 1024;

constexpr int RING_BYTES = 131072;
constexpr int XCH_OFF = RING_BYTES;
constexpr int LDSCTL_OFF = RING_BYTES + 8192, MISC_OFF = LDSCTL_OFF + 320;
constexpr int LDS_BYTES = 147456;

__device__ __forceinline__ unsigned f2bf(float f) { unsigned u = __builtin_bit_cast(unsigned, f); return (u + 0x7fffu + ((u >> 16) & 1u)) >> 16; }
__device__ __forceinline__ unsigned pk2(float lo, float hi) { return f2bf(lo) | (f2bf(hi) << 16); }
__device__ __forceinline__ float bf2f(unsigned short b) { return __builtin_bit_cast(float, ((unsigned)b) << 16); }
__device__ __forceinline__ unsigned cvt_pk_bf16(float lo, float hi) { unsigned r; asm volatile("v_cvt_pk_bf16_f32 %0, %1, %2" : "=v"(r) : "v"(lo), "v"(hi)); return r; }
__device__ __forceinline__ float wave_sum(float v) {
#pragma unroll
    for (int o = 1; o < 64; o <<= 1) v += __shfl_xor(v, o);
    return v;
}
__device__ __forceinline__ float silu_f(float x) { return x / (1.0f + __expf(-x)); }

#define XB_TMO      128
#define XB_XCNT(j)  (256  + 64 * (j))
#define XB_XSUB(j)  (1280 + 64 * (j))
#define XB_XGEN(j)  (2304 + 64 * (j))
#define XB_TOP      3328
#define XB_TOPGEN   3392
#define XCD_BAR_WORDS 3456
#define XB_SPIN_CAP (1u << 20)
__device__ __forceinline__ unsigned xb_ld(unsigned* p)              { return __hip_atomic_load(p, __ATOMIC_RELAXED, __HIP_MEMORY_SCOPE_AGENT); }
__device__ __forceinline__ unsigned xb_add(unsigned* p, unsigned v) { return __hip_atomic_fetch_add(p, v, __ATOMIC_RELAXED, __HIP_MEMORY_SCOPE_AGENT); }
__device__ __forceinline__ unsigned xb_xcc_id() { return (unsigned)__builtin_amdgcn_s_getreg((3 << 11) | 20) & 0xFu; }
#define XB_SPIN(cond, bar) do { unsigned _sp = 0; while (cond) { __builtin_amdgcn_s_sleep(1); \
    if ((++_sp & 255u) == 0u) { if (xb_ld(&(bar)[XB_TMO])) break; if (_sp > XB_SPIN_CAP) { atomicAdd(&(bar)[XB_TMO], 1u); break; } } } } while (0)
struct XcdBarrier { unsigned* bar; unsigned x; volatile LAS unsigned* st; };
__device__ __forceinline__ XcdBarrier xcd_barrier_post(unsigned* bar, volatile LAS unsigned* st) {
    XcdBarrier b; b.bar = bar; b.x = xb_xcc_id(); b.st = st;
    if (threadIdx.x == 0) (void)xb_add(&bar[XB_XCNT(b.x)], 1u);
    return b;
}
__device__ __forceinline__ void xcd_barrier_complete(unsigned* bar, unsigned x, unsigned& nloc, unsigned& nx) {
    const unsigned G = gridDim.x * gridDim.y * gridDim.z;
    unsigned sum, cnt, mine, sp = 0u;
    for (;;) {
        sum = 0u; cnt = 0u; mine = 0u;
#pragma unroll
        for (unsigned j = 0; j < 16; ++j) { const unsigned c = xb_ld(&bar[XB_XCNT(j)]); sum += c; cnt += (c > 0u) ? 1u : 0u; mine = (j == x) ? c : mine; }
        if (sum == G) break;
        __builtin_amdgcn_s_sleep(1);
        if ((++sp & 255u) == 0u) { if (xb_ld(&bar[XB_TMO])) break; if (sp > XB_SPIN_CAP) { atomicAdd(&bar[XB_TMO], 1u); break; } }
    }
    nloc = mine > 0u ? mine : 1u; nx = cnt > 0u ? cnt : 1u;
}
__device__ __forceinline__ void xcd_barrier(const XcdBarrier& b) {
    asm volatile("s_waitcnt vmcnt(0)" ::: "memory");
    __syncthreads();
    if (threadIdx.x == 0) {
        unsigned* bar = b.bar;
        __builtin_amdgcn_s_waitcnt(0);
        unsigned nloc = b.st[0], nx = b.st[1];
        if (nloc == 0u) { xcd_barrier_complete(bar, b.x, nloc, nx); b.st[0] = nloc; b.st[1] = nx; }
        const unsigned old = xb_add(&bar[XB_XSUB(b.x)], 1u);
        const unsigned gen = old / nloc;
        if (old + 1u == (gen + 1u) * nloc) {
            __builtin_amdgcn_fence(__ATOMIC_RELEASE, "agent");
            asm volatile("s_waitcnt vmcnt(0)" ::: "memory");
            const unsigned og = xb_add(&bar[XB_TOP], 1u);
            const unsigned tg = og / nx;
            if (og + 1u == (tg + 1u) * nx) xb_add(&bar[XB_TOPGEN], 1u);
            else XB_SPIN(xb_ld(&bar[XB_TOPGEN]) == tg, bar);
            __builtin_amdgcn_fence(__ATOMIC_ACQUIRE, "agent");
            xb_add(&bar[XB_XGEN(b.x)], 1u);
            asm volatile("s_waitcnt vmcnt(0)" ::: "memory");
        } else {
            XB_SPIN(xb_ld(&bar[XB_XGEN(b.x)]) == gen, bar);
            __builtin_amdgcn_fence(__ATOMIC_ACQUIRE, "agent");
            asm volatile("s_waitcnt vmcnt(0)" ::: "memory");
        }
    }
    __syncthreads();
}

namespace pg8 {
constexpr int BM = 256, BK = 64, HALF = 128, HTB = HALF * BK * 2, STAGE_BYTES = 8 * HTB, NXCD = 8, WGM = 8;
__host__ __device__ __forceinline__ int lds_byte(int r, int c) { const int st = (r >> 4) * 2 + (c >> 5), rr = r & 15, cc = c & 31, ob = rr * 64 + cc * 2; return st * 1024 + (ob ^ (((ob >> 9) & 1) << 5)); }
__host__ __device__ __forceinline__ void stage_rc(int b, int& R, int& C) { const int st = b / 1024, sb = b % 1024, swz = sb ^ (((sb >> 9) & 1) << 5); R = (st >> 1) * 16 + swz / 64; C = (st & 1) * 32 + (swz % 64) / 2; }
__host__ __device__ __forceinline__ int perm32(int rho) { const int n = rho >> 4, i = rho & 15; return 8 * (i >> 2) + 4 * n + (i & 3); }
}

enum GemmKind { GK_FFN1 = 0, GK_FFN2, GK_F1, GK_F2S, GK_F2P, GK_POOL, GK_A1, GK_A3Q, GK_A3KV, GK_A5, GK_WCOMB };
enum EpiKind { EK_XRES = 0, EK_BF16, EK_F32, EK_FFN1 };

typedef long long modacc_t;
struct EUnit {
    char* o0; char* o1;
    const float* aux;
    const modacc_t* gate;
    const float* aux2;
    int i0, i1, i2, i3;
};
struct GemmDesc {
    int kind, epi, perm;
    int total, lda, ldb;
    int hsA, hsB;
    int ldc0, ldc1;
    int layer, li;
};

struct Args { const float* in[23]; float* out; unsigned char* ws; int ph_lo, ph_hi; };

__device__ __forceinline__ void grid_order(int L, int nM, int nN, int& pm, int& pn) {
    const int nwg = nM * nN; int wgid = L;
    { const int q = nwg / pg8::NXCD, r = nwg % pg8::NXCD, xcd = wgid % pg8::NXCD, off = wgid / pg8::NXCD; wgid = (xcd < r ? xcd * (q + 1) : r * (q + 1) + (xcd - r) * q) + off; }
    const int nig = pg8::WGM * nN, gid = wgid / nig, fm = gid * pg8::WGM, gsz = (nM - fm) < pg8::WGM ? (nM - fm) : pg8::WGM;
    pm = fm + ((wgid % nig) % gsz); pn = (wgid % nig) / gsz;
}
__device__ __forceinline__ const modacc_t* mod_vec(const unsigned char* ws, int layer, int tok, int which) {
    const int cond = tok < NP ? 0 : 1 + (tok - NP) / SSEQ;
    return (const modacc_t*)(ws + WS_CTL + CTL_MOD_OFF) + ((size_t)(layer * 3 + cond) * 6144 + which * 1024);
}
typedef long long i64x2 __attribute__((ext_vector_type(2)));
__device__ __forceinline__ f32x4 mod_ld4(const modacc_t* p) {
    const i64x2 a = *(const i64x2*)p, b = *(const i64x2*)(p + 2);
    f32x4 r; r.x = (float)a.x * 2.3283064365386963e-10f; r.y = (float)a.y * 2.3283064365386963e-10f; r.z = (float)b.x * 2.3283064365386963e-10f; r.w = (float)b.y * 2.3283064365386963e-10f;
    return r;
}
__device__ __forceinline__ void ffn1_tile(int pm, int& tok0, int& p0, int& T, int& rlo, int& rhi) {
    if (pm < 32) { tok0 = pm * 256; p0 = 0; T = 256; rlo = 0; rhi = 256; }
    else { const int j9 = pm - 32, b = j9 / 9, j = j9 % 9; p0 = 254 * j - 1; tok0 = NP + b * SSEQ + p0; T = SSEQ; rlo = 1; rhi = (SSEQ - p0) < 255 ? (SSEQ - p0) : 255; }
}

__device__ __forceinline__ void get_ab(const GemmDesc& g, const unsigned char* ws, int L, const char*& A, const char*& B, int& nt) {
    switch (g.kind) {
    case GK_FFN1: { int pm, pn; grid_order(L, 50, 22, pm, pn); int tok0, p0, T, rlo, rhi; ffn1_tile(pm, tok0, p0, T, rlo, rhi);
        A = (const char*)(ws + WS_H) + (long)tok0 * DM * 2;
        B = (const char*)(ws + WS_WIN) + ((size_t)g.layer * DFF2 + 128 * pn) * DM * 2; nt = 16; } break;
    case GK_FFN2: { int pm, pn; grid_order(L, 48, 4, pm, pn);
        A = (const char*)(ws + S_G) + (size_t)pm * 256 * DFF * 2;
        B = (const char*)(ws + WS_WOUT) + ((size_t)g.layer * DM + pn * 256) * DFF * 2; nt = 44; } break;
    case GK_F1: { int pm, pn; grid_order(L, 8, 48, pm, pn);
        A = (const char*)(ws + WS_WCS) + ((size_t)g.li * 2048 + pm * 256) * DM * 2;
        B = (const char*)(ws + WS_H) + (size_t)pn * 256 * DM * 2; nt = 16; } break;
    case GK_F2S: { const int b = L / 32, mt = (L % 32) / 4, pn = L % 4;
        A = (const char*)(ws + WS_DFTS) + (size_t)mt * 256 * 4096 * 2;
        B = (const char*)(ws + S_ZF) + (size_t)NPB * 1024 * 512 * 2 + ((size_t)b * 1024 + pn * 256) * 4096 * 2; nt = 64; } break;
    case GK_F2P: { const int b = L / 4, pn = L % 4;
        A = (const char*)(ws + WS_DFTP);
        B = (const char*)(ws + S_ZF) + ((size_t)b * 1024 + pn * 256) * 512 * 2; nt = 8; } break;
    case GK_POOL: { int pm, pn; grid_order(L, 48, 4, pm, pn);
        A = (const char*)(ws + S_PL) + ((size_t)pm * 256 * DM + pn * 256) * 2;
        B = (const char*)(ws + WS_WPT) + (size_t)pn * 256 * 256 * 2; nt = 4; } break;
    case GK_A1: { int pm, pn; grid_order(L, 48, 6, pm, pn);
        A = (const char*)(ws + WS_H) + (size_t)pm * 256 * DM * 2;
        B = (const char*)(ws + WS_WDT) + (size_t)pn * 256 * DM * 2; nt = 16; } break;
    case GK_A3Q: { int pm, pn; grid_order(L, 48, 6, pm, pn);
        A = (const char*)(ws + S_CQ) + (size_t)pm * 256 * QRANK * 2;
        B = (const char*)(ws + WS_WUQT) + (size_t)pn * 256 * QRANK * 2; nt = 12; } break;
    case GK_A3KV: { int pm, pn; grid_order(L, 50, 8, pm, pn);
        A = (const char*)(ws + S_CALL) + (size_t)pm * 256 * KVRANK * 2;
        B = (const char*)(ws + WS_WUKVT) + (size_t)pn * 256 * KVRANK * 2; nt = 8; } break;
    case GK_A5: { int pm, pn; grid_order(L, 48, 4, pm, pn);
        A = (const char*)(ws + S_O) + (size_t)pm * 256 * DM * 2;
        B = (const char*)(ws + WS_WOT) + (size_t)pn * 256 * DM * 2; nt = 16; } break;
    default: {
        const int l = L / 32, r = L % 32, gq = r / 8, pm = (r % 8) / 2, pn = r % 2;
        A = (const char*)(ws + WS_WFT) + ((size_t)l * 1024 * 1024 + (size_t)pm * 256 * 1024 + gq * 256) * 2;
        B = (const char*)(ws + WS_C256) + (size_t)pn * 256 * 256 * 2; nt = 4; } break;
    }
}
__device__ __forceinline__ void get_epi(const GemmDesc& g, unsigned char* ws, const float* cw, const float* cb, int L, EUnit& u) {
    u.aux = nullptr; u.aux2 = nullptr; u.gate = nullptr; u.o1 = nullptr; u.i0 = u.i1 = u.i2 = u.i3 = 0;
    switch (g.kind) {
    case GK_FFN1: { int pm, pn; grid_order(L, 50, 22, pm, pn); int tok0, p0, T, rlo, rhi; ffn1_tile(pm, tok0, p0, T, rlo, rhi);
        u.o0 = (char*)(ws + S_G) + ((long)tok0 * DFF + 128 * pn) * 2;
        u.aux = cw + (size_t)g.layer * 3 * DFF2 + 128 * pn;
        u.aux2 = cb + (size_t)g.layer * DFF2 + 128 * pn;
        u.i0 = p0; u.i1 = T; u.i2 = rlo; u.i3 = rhi; } break;
    case GK_FFN2: { int pm, pn; grid_order(L, 48, 4, pm, pn);
        u.o0 = (char*)(ws + WS_X) + ((size_t)pm * 256 * DM + pn * 256) * 4; u.gate = mod_vec(ws, g.layer, pm * 256, 5) + pn * 256; } break;
    case GK_F1: { int pm, pn; grid_order(L, 8, 48, pm, pn);
        const int part = pm >> 2, n0 = (pm & 3) * 256, tok0 = pn * 256;
        char* zb; int T, s0;
        if (tok0 < NP) { T = PSEQ; s0 = 0; zb = (char*)(ws + S_ZF) + (size_t)(tok0 / PSEQ) * 1024 * 512 * 2; }
        else { T = SSEQ; const int b = (tok0 - NP) / SSEQ; s0 = (tok0 - NP) % SSEQ; zb = (char*)(ws + S_ZF) + (size_t)NPB * 1024 * 512 * 2 + (size_t)b * 1024 * 4096 * 2; }
        u.o0 = zb + ((size_t)n0 * 2 * T + part * T + s0) * 2; u.o1 = u.o0 + 128 * 2; u.i0 = 2 * T; } break;
    case GK_F2S: { const int b = L / 32, mt = (L % 32) / 4, pn = L % 4; const int tok0 = NP + b * SSEQ + mt * 256;
        u.o0 = (char*)(ws + WS_X) + ((size_t)tok0 * DM + pn * 256) * 4; u.gate = mod_vec(ws, g.layer, tok0, 2) + pn * 256; } break;
    case GK_F2P: { const int b = L / 4, pn = L % 4; const int tok0 = b * PSEQ;
        u.o0 = (char*)(ws + WS_X) + ((size_t)tok0 * DM + pn * 256) * 4; u.gate = mod_vec(ws, g.layer, tok0, 2) + pn * 256; } break;
    case GK_POOL: { int pm, pn; grid_order(L, 48, 4, pm, pn);
        u.o0 = (char*)(ws + WS_X) + ((size_t)pm * 256 * DM + pn * 256) * 4; u.gate = mod_vec(ws, g.layer, pm * 256, 2) + pn * 256; } break;
    case GK_A1: { int pm, pn; grid_order(L, 48, 6, pm, pn);
        u.o0 = (char*)(ws + S_RAW) + ((size_t)pm * 256 * NDOWN + pn * 256) * 4; } break;
    case GK_A3Q: { int pm, pn; grid_order(L, 48, 6, pm, pn);
        u.o0 = (char*)(ws + S_QF) + ((size_t)pm * 256 * 1536 + pn * 256) * 2; u.o1 = u.o0 + 128 * 2; } break;
    case GK_A3KV: { int pm, pn; grid_order(L, 50, 8, pm, pn);
        u.o0 = (char*)(ws + S_KF) + ((size_t)pm * 256 * 1536 + pn * QKD) * 2;
        u.o1 = (char*)(ws + S_VF) + ((size_t)pm * 256 * 1024 + pn * VD) * 2; } break;
    case GK_A5: { int pm, pn; grid_order(L, 48, 4, pm, pn);
        u.o0 = (char*)(ws + WS_X) + ((size_t)pm * 256 * DM + pn * 256) * 4; u.gate = mod_vec(ws, g.layer, pm * 256, 2) + pn * 256; } break;
    default: { const int l = L / 32, r = L % 32, gq = r / 8, pm = (r % 8) / 2, pn = r % 2;
        u.o0 = (char*)(ws + WS_WCS) + (((size_t)l * 2048 + pn * 1024 + pm * 256) * 1024 + gq * 256) * 2; u.o1 = u.o0 + 128 * 2; } break;
    }
}

typedef f32x4 Acc[2][2][4][2];

__device__ __forceinline__ void epi_xres(const Acc& acc, const EUnit& u, int wr, int wc, int fr, int fq) {
    float* X0 = (float*)u.o0; const int cb = wc * 32 + 4 * fq;
    f32x4 gv[2][2];
#pragma unroll
    for (int bj = 0; bj < 2; ++bj)
#pragma unroll
        for (int n = 0; n < 2; ++n) gv[bj][n] = mod_ld4(u.gate + cb + bj * 128 + n * 16);
#pragma unroll
    for (int ai = 0; ai < 2; ++ai)
#pragma unroll
        for (int m = 0; m < 4; ++m) { float* rowp = X0 + (size_t)(ai * 128 + wr * 64 + m * 16 + fr) * DM + cb;
#pragma unroll
            for (int bj = 0; bj < 2; ++bj)
#pragma unroll
                for (int n = 0; n < 2; ++n) { f32x4* p = (f32x4*)(rowp + bj * 128 + n * 16); const f32x4 xv = *p; *p = xv + gv[bj][n] * acc[ai][bj][m][n]; } }
}
__device__ __forceinline__ void epi_f32(const Acc& acc, const EUnit& u, int ldc, int wr, int wc, int fr, int fq) {
    float* C0 = (float*)u.o0; const int cb = wc * 32 + 4 * fq;
#pragma unroll
    for (int ai = 0; ai < 2; ++ai)
#pragma unroll
        for (int m = 0; m < 4; ++m) { float* rowp = C0 + (size_t)(ai * 128 + wr * 64 + m * 16 + fr) * ldc + cb;
#pragma unroll
            for (int bj = 0; bj < 2; ++bj)
#pragma unroll
                for (int n = 0; n < 2; ++n) *(f32x4*)(rowp + bj * 128 + n * 16) = acc[ai][bj][m][n]; }
}
__device__ __forceinline__ void epi_bf16(const Acc& acc, const EUnit& u, int ldc0, int ldc1, int wr, int wc, int fr, int fq) {
    const int cb = wc * 32 + 8 * fq;
#pragma unroll
    for (int ai = 0; ai < 2; ++ai)
#pragma unroll
        for (int m = 0; m < 4; ++m) { const int r = ai * 128 + wr * 64 + m * 16 + fr;
#pragma unroll
            for (int bj = 0; bj < 2; ++bj) { bf16_t* dst = (bf16_t*)(bj ? u.o1 : u.o0) + (size_t)r * (bj ? ldc1 : ldc0) + cb;
                const f32x4 v0 = acc[ai][bj][m][0], v1 = acc[ai][bj][m][1];
                u32x4 w; w.x = cvt_pk_bf16(v0[0], v0[1]); w.y = cvt_pk_bf16(v0[2], v0[3]); w.z = cvt_pk_bf16(v1[0], v1[1]); w.w = cvt_pk_bf16(v1[2], v1[3]);
                *(u32x4*)dst = w; } }
}
__device__ __forceinline__ void epi_ffn1(Acc& acc, const EUnit& u, LAS unsigned char* lds, int wr, int wc, int fr, int fq, int lane) {
    const int p0 = u.i0, T = u.i1, rlo = u.i2, rhi = u.i3;
    if (p0 < 0 || p0 + 256 > T) {
#pragma unroll
        for (int ai = 0; ai < 2; ++ai)
#pragma unroll
            for (int m = 0; m < 4; ++m) { const int p = p0 + ai * 128 + wr * 64 + m * 16 + fr; const bool ok = (p >= 0) && (p < T);
#pragma unroll
                for (int bj = 0; bj < 2; ++bj)
#pragma unroll
                    for (int n = 0; n < 2; ++n) { f32x4 v = acc[ai][bj][m][n]; v[0] = ok ? v[0] : 0.f; v[1] = ok ? v[1] : 0.f; v[2] = ok ? v[2] : 0.f; v[3] = ok ? v[3] : 0.f; acc[ai][bj][m][n] = v; } }
    }
    LAS float* XCH = (LAS float*)(lds + XCH_OFF);
    const int cw8 = wc * 32 + 8 * fq;
    if (fr == 0 || fr == 15) {
        const int e = (fr == 15) ? 1 : 0, mm = (fr == 15) ? 3 : 0;
#pragma unroll
        for (int ai = 0; ai < 2; ++ai)
#pragma unroll
            for (int bj = 0; bj < 2; ++bj)
#pragma unroll
                for (int n = 0; n < 2; ++n) {
                    const f32x4 v = (mm == 3) ? acc[ai][bj][3][n] : acc[ai][bj][0][n];
                    *(LAS f32x4*)(XCH + ((2 * ai + wr) * 2 + e) * 256 + bj * 128 + cw8 + 4 * n) = v; }
    }
    asm volatile("s_waitcnt lgkmcnt(0)" ::: "memory"); __builtin_amdgcn_s_barrier(); asm volatile("" ::: "memory");
    const int srcUp = (lane & 48) | ((lane - 1) & 15), srcDn = (lane & 48) | ((lane + 1) & 15);
    const float* wcv = u.aux; const float* bcv = u.aux2;
    unsigned packed[2][4][4];
#pragma unroll
    for (int n = 0; n < 2; ++n) {
        const int cc = cw8 + 4 * n;
        const f32x4 w0g = *(const f32x4*)(wcv + cc), w1g = *(const f32x4*)(wcv + DFF2 + cc), w2g = *(const f32x4*)(wcv + 2 * DFF2 + cc), bg = *(const f32x4*)(bcv + cc);
        const f32x4 w0v = *(const f32x4*)(wcv + DFF + cc), w1v = *(const f32x4*)(wcv + DFF2 + DFF + cc), w2v = *(const f32x4*)(wcv + 2 * DFF2 + DFF + cc), bv = *(const f32x4*)(bcv + DFF + cc);
#pragma unroll
        for (int ai = 0; ai < 2; ++ai) {
            const int q = 2 * ai + wr;
            f32x4 htop[2], hbot[2];
#pragma unroll
            for (int bj = 0; bj < 2; ++bj) {
                htop[bj] = (q > 0) ? *(const LAS f32x4*)(XCH + ((q - 1) * 2 + 1) * 256 + bj * 128 + cc) : (f32x4){0.f, 0.f, 0.f, 0.f};
                hbot[bj] = (q < 3) ? *(const LAS f32x4*)(XCH + ((q + 1) * 2 + 0) * 256 + bj * 128 + cc) : (f32x4){0.f, 0.f, 0.f, 0.f};
            }
#pragma unroll
            for (int m = 0; m < 4; ++m) {
                f32x4 uu[2];
#pragma unroll
                for (int bj = 0; bj < 2; ++bj) {
                    const f32x4 cur = acc[ai][bj][m][n];
                    const f32x4 prv = (m > 0) ? acc[ai][bj][m > 0 ? m - 1 : 0][n] : cur;
                    const f32x4 nxt = (m < 3) ? acc[ai][bj][m < 3 ? m + 1 : 3][n] : cur;
                    f32x4 up, dn;
#pragma unroll
                    for (int e = 0; e < 4; ++e) {
                        const float su = (fr == 15) ? prv[e] : cur[e];
                        const float sd = (fr == 0) ? nxt[e] : cur[e];
                        up[e] = __shfl(su, srcUp); dn[e] = __shfl(sd, srcDn);
                    }
                    if (m == 0) { up[0] = (fr == 0) ? htop[bj][0] : up[0]; up[1] = (fr == 0) ? htop[bj][1] : up[1]; up[2] = (fr == 0) ? htop[bj][2] : up[2]; up[3] = (fr == 0) ? htop[bj][3] : up[3]; }
                    if (m == 3) { dn[0] = (fr == 15) ? hbot[bj][0] : dn[0]; dn[1] = (fr == 15) ? hbot[bj][1] : dn[1]; dn[2] = (fr == 15) ? hbot[bj][2] : dn[2]; dn[3] = (fr == 15) ? hbot[bj][3] : dn[3]; }
                    const f32x4 w0 = bj ? w0v : w0g, w1 = bj ? w1v : w1g, w2 = bj ? w2v : w2g, bb = bj ? bv : bg;
                    uu[bj] = w0 * up + w1 * cur + w2 * dn + bb;
                }
                f32x4 o;
#pragma unroll
                for (int e = 0; e < 4; ++e) { const float gt = uu[0][e]; o[e] = gt * __builtin_amdgcn_rcpf(1.0f + __expf(-gt)) * uu[1][e]; }
                packed[ai][m][2 * n] = cvt_pk_bf16(o[0], o[1]); packed[ai][m][2 * n + 1] = cvt_pk_bf16(o[2], o[3]);
            }
        }
    }
    bf16_t* G0 = (bf16_t*)u.o0;
#pragma unroll
    for (int ai = 0; ai < 2; ++ai)
#pragma unroll
        for (int m = 0; m < 4; ++m) { const int r = ai * 128 + wr * 64 + m * 16 + fr;
            if (r >= rlo && r < rhi) { u32x4 w; w.x = packed[ai][m][0]; w.y = packed[ai][m][1]; w.z = packed[ai][m][2]; w.w = packed[ai][m][3];
                *(u32x4*)(G0 + (long)r * DFF + cw8) = w; } }
}

__device__ __forceinline__ void gemm_phase(LAS unsigned char* lds, const GemmDesc& g, unsigned char* ws, const float* cw, const float* cb, int G, int c) {
    using namespace pg8;
    int tid_ = threadIdx.x; asm volatile("" : "+v"(tid_));
    const int tid = tid_, wid = __builtin_amdgcn_readfirstlane(tid >> 6), lane = tid & 63, wr = wid >> 2, wc = wid & 3, fr = lane & 15, fq = lane >> 4;
    if (c >= g.total) return;
    unsigned voffA[2], voffB[2];
#pragma unroll
    for (int i = 0; i < 2; ++i) { int R, C; stage_rc(tid * 16 + i * 8192, R, C); const int Rb = g.perm ? ((R & ~31) + perm32(R & 31)) : R;
        voffA[i] = (unsigned)(R * g.lda + C) * 2u; voffB[i] = (unsigned)(Rb * g.ldb + C) * 2u; }
    const size_t kstep = (size_t)(BK * 2);
    const size_t hsA = (size_t)g.hsA, hsB = (size_t)g.hsB;
    const unsigned ldsw = (unsigned)wid * 1024u;
    const int aoff = lds_byte(wr * 64 + fr, fq * 8), boff = lds_byte(wc * 32 + fr, fq * 8);
#define PG8_SA(b, h) (((b) * 2 + (h)) * HTB)
#define PG8_SB(b, h) ((4 + (b) * 2 + (h)) * HTB)
#define PG8_STAGE(bufoff, gbase, voff) do { _Pragma("unroll") for (int _i = 0; _i < 2; ++_i) \
        __builtin_amdgcn_global_load_lds((const unsigned*)((const char*)(gbase) + (voff)[_i]), (LAS unsigned*)(lds + (bufoff) + ldsw + _i * 8192), 16, 0, 0); } while (0)
#define PG8_LDA(dst, b, h) do { _Pragma("unroll") for (int m = 0; m < 4; ++m) _Pragma("unroll") for (int k = 0; k < 2; ++k) dst[m][k] = *(const LAS bf16x8*)(lds + PG8_SA(b, h) + aoff + m * 2048 + k * 1024); } while (0)
#define PG8_LDB(dst, b, h) do { _Pragma("unroll") for (int n = 0; n < 2; ++n) _Pragma("unroll") for (int k = 0; k < 2; ++k) dst[n][k] = *(const LAS bf16x8*)(lds + PG8_SB(b, h) + boff + n * 2048 + k * 1024); } while (0)
#define PG8_MMA(ai, bj, At, Bt) do { __builtin_amdgcn_s_setprio(1); _Pragma("unroll") for (int m = 0; m < 4; ++m) _Pragma("unroll") for (int n = 0; n < 2; ++n) _Pragma("unroll") for (int k = 0; k < 2; ++k) \
        acc[ai][bj][m][n] = __builtin_amdgcn_mfma_f32_16x16x32_bf16(Bt[n][k], At[m][k], acc[ai][bj][m][n], 0, 0, 0); __builtin_amdgcn_s_setprio(0); } while (0)
#define PG8_WAIT_V(n) asm volatile("s_waitcnt vmcnt(" #n ")" ::: "memory")
#define PG8_WAIT_L(n) asm volatile("s_waitcnt lgkmcnt(" #n ")" ::: "memory")
#define PG8_BAR __builtin_amdgcn_s_barrier()
#define PG8_SCHED __builtin_amdgcn_sched_barrier(0)
    int L = c, nt;
    const char* cA; const char* cB;
    get_ab(g, ws, L, cA, cB, nt);
    Acc acc;
#pragma unroll
    for (int a = 0; a < 2; ++a)
#pragma unroll
        for (int b = 0; b < 2; ++b)
#pragma unroll
            for (int m = 0; m < 4; ++m)
#pragma unroll
                for (int n = 0; n < 2; ++n) acc[a][b][m][n] = (f32x4){0.f, 0.f, 0.f, 0.f};
    bf16x8 At[4][2], B0[2][2], B1[2][2];
    PG8_STAGE(PG8_SB(0, 0), cB, voffB); PG8_STAGE(PG8_SB(0, 1), cB + hsB, voffB); PG8_STAGE(PG8_SA(0, 0), cA, voffA); PG8_STAGE(PG8_SA(0, 1), cA + hsA, voffA);
    if (wr == 1) PG8_BAR;
    PG8_WAIT_V(2); PG8_BAR;
    PG8_STAGE(PG8_SB(1, 0), cB + kstep, voffB); PG8_STAGE(PG8_SA(1, 0), cA + kstep, voffA); PG8_STAGE(PG8_SB(1, 1), cB + hsB + kstep, voffB);
    PG8_WAIT_V(6); PG8_BAR;
    for (;;) {
        const bool has_next = (L + G) < g.total;
        const char* nA = cA; const char* nB = cB; int nnt = nt;
        if (has_next) get_ab(g, ws, L + G, nA, nB, nnt);
        for (int t = 0; t < nt; t += 2) {
            const bool last = (t == nt - 2);
            const char* a1 = cA + (size_t)(t + 1) * kstep;
            const char* a2 = last ? nA : cA + (size_t)(t + 2) * kstep; const char* b2 = last ? nB : cB + (size_t)(t + 2) * kstep;
            const char* a3 = a2 + kstep; const char* b3 = b2 + kstep;
            PG8_LDB(B0, 0, 0); PG8_LDB(B1, 0, 1); PG8_SCHED; PG8_LDA(At, 0, 0); PG8_STAGE(PG8_SA(1, 1), a1 + hsA, voffA);
            PG8_WAIT_V(8); PG8_WAIT_L(0); PG8_BAR; PG8_MMA(0, 0, At, B0); PG8_MMA(0, 1, At, B1); PG8_BAR; PG8_SCHED;
            PG8_LDA(At, 0, 1); PG8_STAGE(PG8_SB(0, 0), b2, voffB); PG8_STAGE(PG8_SB(0, 1), b2 + hsB, voffB); PG8_STAGE(PG8_SA(0, 0), a2, voffA);
            PG8_WAIT_V(8); PG8_WAIT_L(0); PG8_BAR; PG8_MMA(1, 0, At, B0); PG8_MMA(1, 1, At, B1); PG8_BAR; PG8_SCHED;
            PG8_LDB(B0, 1, 0); PG8_LDB(B1, 1, 1); PG8_SCHED; PG8_LDA(At, 1, 0); PG8_STAGE(PG8_SA(0, 1), a2 + hsA, voffA);
            PG8_WAIT_V(8); PG8_WAIT_L(0); PG8_BAR; PG8_MMA(0, 0, At, B0); PG8_MMA(0, 1, At, B1); PG8_BAR; PG8_SCHED;
            PG8_LDA(At, 1, 1); PG8_STAGE(PG8_SB(1, 0), b3, voffB); PG8_STAGE(PG8_SB(1, 1), b3 + hsB, voffB); PG8_STAGE(PG8_SA(1, 0), a3, voffA);
            PG8_WAIT_V(8); PG8_WAIT_L(0); PG8_BAR; PG8_MMA(1, 0, At, B0); PG8_MMA(1, 1, At, B1); PG8_BAR; PG8_SCHED;
        }
        if (wr == 0) PG8_BAR;
        { EUnit eu; get_epi(g, ws, cw, cb, L, eu);
          int efr = fr, efq = fq, elane = lane; asm volatile("" : "+v"(efr), "+v"(efq), "+v"(elane));
          switch (g.epi) {
          case EK_XRES: epi_xres(acc, eu, wr, wc, efr, efq); break;
          case EK_BF16: epi_bf16(acc, eu, g.kind == GK_F1 ? eu.i0 : g.ldc0, g.kind == GK_F1 ? eu.i0 : g.ldc1, wr, wc, efr, efq); break;
          case EK_F32: epi_f32(acc, eu, g.ldc0, wr, wc, efr, efq); break;
          default: epi_ffn1(acc, eu, lds, wr, wc, efr, efq, elane); break;
          } }
        if (!has_next) break;
#pragma unroll
        for (int a = 0; a < 2; ++a)
#pragma unroll
            for (int b = 0; b < 2; ++b)
#pragma unroll
                for (int m = 0; m < 4; ++m)
#pragma unroll
                    for (int n = 0; n < 2; ++n) acc[a][b][m][n] = (f32x4){0.f, 0.f, 0.f, 0.f};
        L += G; cA = nA; cB = nB; nt = nnt;
        if (wr == 1) PG8_BAR;
    }
    PG8_WAIT_V(0);
    PG8_BAR;
#undef PG8_SA
#undef PG8_SB
#undef PG8_STAGE
#undef PG8_LDA
#undef PG8_LDB
#undef PG8_MMA
#undef PG8_WAIT_V
#undef PG8_WAIT_L
#undef PG8_BAR
#undef PG8_SCHED
}

__device__ __forceinline__ int opaque_tid() { int t = threadIdx.x; asm volatile("" : "+v"(t)); return t; }
struct Frame {
    LAS unsigned char* lds; unsigned char* ws; float* out;
    int wave, vcu, G, gw, ngw;
};

__device__ __forceinline__ void pass_modulate(Frame& F, int layer, int which) {
    const int tid = opaque_tid(), lane = tid & 63; (void)tid;
    const float* X = (const float*)(F.ws + WS_X); bf16_t* H = (bf16_t*)(F.ws + WS_H);
    for (int tok = F.gw; tok < NTOK; tok += F.ngw) {
        const f32x4* xr = (const f32x4*)(X + (size_t)tok * DM) + lane;
        f32x4 v[4]; float s = 0.f;
#pragma unroll
        for (int j = 0; j < 4; ++j) { v[j] = xr[64 * j]; s += (v[j].x * v[j].x + v[j].y * v[j].y) + (v[j].z * v[j].z + v[j].w * v[j].w); }
        const float rstd = 1.0f / sqrtf(wave_sum(s) * (1.0f / DM) + EPS);
        const modacc_t* sh = mod_vec(F.ws, layer, tok, which) + 4 * lane;
        const modacc_t* sc = mod_vec(F.ws, layer, tok, which + 1) + 4 * lane;
        u32x2* o8 = (u32x2*)(H + (size_t)tok * DM) + lane;
#pragma unroll
        for (int j = 0; j < 4; ++j) { const f32x4 a = mod_ld4(sh + 256 * j), b = mod_ld4(sc + 256 * j); const f32x4 h = v[j] * rstd * (b + 1.0f) + a;
            u32x2 w; w.x = pk2(h.x, h.y); w.y = pk2(h.z, h.w); o8[64 * j] = w; }
    }
}
__device__ __forceinline__ void pass_final(Frame& F, const Args& A) {
    const int tid = opaque_tid(), lane = tid & 63; (void)tid;
    const float* X = (const float*)(F.ws + WS_X); const float* gf = A.in[22];
    for (int tok = F.gw; tok < NTOK; tok += F.ngw) {
        const f32x4* xr = (const f32x4*)(X + (size_t)tok * DM) + lane;
        f32x4 v[4]; float s = 0.f;
#pragma unroll
        for (int j = 0; j < 4; ++j) { v[j] = xr[64 * j]; s += (v[j].x * v[j].x + v[j].y * v[j].y) + (v[j].z * v[j].z + v[j].w * v[j].w); }
        const float rstd = 1.0f / sqrtf(wave_sum(s) * (1.0f / DM) + EPS);
        f32x4* o = (f32x4*)(F.out + (size_t)tok * DM) + lane;
#pragma unroll
        for (int j = 0; j < 4; ++j) { const f32x4 g = ((const f32x4*)gf)[lane + 64 * j]; o[64 * j] = v[j] * rstd * g; }
    }
}
__device__ __forceinline__ void pass_pool(Frame& F) {
    const int tid = opaque_tid(), lane = tid & 63; (void)tid;
    const bf16_t* H = (const bf16_t*)(F.ws + WS_H); bf16_t* PL = (bf16_t*)(F.ws + S_PL);
    for (int tok = F.gw; tok < NTOK; tok += F.ngw) {
        int base, T, t;
        if (tok < NP) { base = tok & ~(PSEQ - 1); T = PSEQ; t = tok - base; } else { const int r = tok - NP; base = NP + (r & ~(SSEQ - 1)); T = SSEQ; t = tok - base; }
#pragma unroll
        for (int j = 0; j < 4; ++j) {
            const int w = 2 << j; int lo = t - w / 2; if (lo < 0) lo = 0; int hi = t - w / 2 + w; if (hi > T) hi = T;
            float s0 = 0.f, s1 = 0.f, s2 = 0.f, s3 = 0.f;
            for (int tt = lo; tt < hi; ++tt) { const u32x2 q = *((const u32x2*)(H + (size_t)(base + tt) * DM + 256 * j) + lane);
                s0 += __builtin_bit_cast(float, q.x << 16); s1 += __builtin_bit_cast(float, q.x & 0xffff0000u); s2 += __builtin_bit_cast(float, q.y << 16); s3 += __builtin_bit_cast(float, q.y & 0xffff0000u); }
            const u32x2 q = *((const u32x2*)(H + (size_t)tok * DM + 256 * j) + lane);
            const float inv = 1.0f / (float)(hi - lo);
            const float o0 = s0 * inv - __builtin_bit_cast(float, q.x << 16), o1 = s1 * inv - __builtin_bit_cast(float, q.x & 0xffff0000u);
            const float o2 = s2 * inv - __builtin_bit_cast(float, q.y << 16), o3 = s3 * inv - __builtin_bit_cast(float, q.y & 0xffff0000u);
            u32x2 w2; w2.x = pk2(o0, o1); w2.y = pk2(o2, o3);
            *((u32x2*)(PL + (size_t)tok * DM + 256 * j) + lane) = w2;
        }
    }
}
__device__ __forceinline__ void pass_mla_norm(Frame& F, const Args& A) {
    const int tid = opaque_tid(), lane = tid & 63; (void)tid;
    const float* RAW = (const float*)(F.ws + S_RAW); bf16_t* CQ = (bf16_t*)(F.ws + S_CQ); bf16_t* CALL = (bf16_t*)(F.ws + S_CALL); bf16_t* KF = (bf16_t*)(F.ws + S_KF);
    const float* gq = A.in[12]; const float* gkv = A.in[15];
    float* st_ckv = F.out + (size_t)NTOK * DM; float* st_kpe = st_ckv + (size_t)NP * KVRANK;
    for (int tok = F.gw; tok < NTOK; tok += F.ngw) {
        const float* rr = RAW + (size_t)tok * NDOWN;
        int krow; if (tok < NP) krow = tok; else { const int r = tok - NP; krow = NP + (r / SSEQ) * SKV + PAST + (r % SSEQ); }
        { f32x4 v[3]; float s = 0.f;
#pragma unroll
          for (int j = 0; j < 3; ++j) { v[j] = ((const f32x4*)rr)[lane + 64 * j]; s += (v[j].x * v[j].x + v[j].y * v[j].y) + (v[j].z * v[j].z + v[j].w * v[j].w); }
          const float rstd = 1.0f / sqrtf(wave_sum(s) * (1.0f / QRANK) + EPS);
#pragma unroll
          for (int j = 0; j < 3; ++j) { const f32x4 g = ((const f32x4*)gq)[lane + 64 * j]; const f32x4 h = v[j] * rstd * g; u32x2 w; w.x = pk2(h.x, h.y); w.y = pk2(h.z, h.w);
              *((u32x2*)(CQ + (size_t)tok * QRANK) + lane + 64 * j) = w; } }
        { f32x4 v[2]; float s = 0.f;
#pragma unroll
          for (int j = 0; j < 2; ++j) { v[j] = ((const f32x4*)(rr + QRANK))[lane + 64 * j]; s += (v[j].x * v[j].x + v[j].y * v[j].y) + (v[j].z * v[j].z + v[j].w * v[j].w); }
          const float rstd = 1.0f / sqrtf(wave_sum(s) * (1.0f / KVRANK) + EPS);
#pragma unroll
          for (int j = 0; j < 2; ++j) { const f32x4 g = ((const f32x4*)gkv)[lane + 64 * j]; const f32x4 h = v[j] * rstd * g; u32x2 w; w.x = pk2(h.x, h.y); w.y = pk2(h.z, h.w);
              *((u32x2*)(CALL + (size_t)krow * KVRANK) + lane + 64 * j) = w;
              if (tok < NP) ((f32x4*)(st_ckv + (size_t)tok * KVRANK))[lane + 64 * j] = h; } }
        { float x = rr[QRANK + KVRANK + lane];
          if (tok < NP) { st_kpe[(size_t)tok * ROPE + lane] = x; }
          else { const int t = (tok - NP) % SSEQ; const int pos = (lane < 32) ? (t >> 6) : (t & 63);
              const float inv = __builtin_amdgcn_exp2f(-(float)(lane & 15) * 0.8304820237218407f);
              const float rev = (float)pos * inv * 0.15915494309189535f;
              const float cs = __builtin_amdgcn_cosf(rev), sn = __builtin_amdgcn_sinf(rev);
              const float partner = __shfl_xor(x, 16);
              x = (lane & 16) ? (x * cs + partner * sn) : (x * cs - partner * sn); }
          const bf16_t xb = (bf16_t)f2bf(x);
#pragma unroll
          for (int h = 0; h < NHEAD; ++h) KF[(size_t)krow * 1536 + h * QKD + 128 + lane] = xb; }
    }
}

__device__ __forceinline__ void xpose_item(const float* W, int N, bf16_t* WT, int ldk, const float* rscale, LAS float* scr, int item, int lane) {
    const int nblk = N / 32, kb = item / nblk, nb = item % nblk, k0 = 64 * kb, n0 = 32 * nb;
#pragma unroll 8
    for (int i = 0; i < 32; ++i) { const int kk = 2 * i + (lane >> 5); scr[kk * 33 + (lane & 31)] = W[(size_t)(k0 + kk) * N + n0 + (lane & 31)]; }
    asm volatile("s_waitcnt lgkmcnt(0)" ::: "memory");
    const int c = lane & 7;
#pragma unroll
    for (int j = 0; j < 4; ++j) { const int n = (lane >> 3) + 8 * j; const LAS float* s = scr + (8 * c) * 33 + n; const float sc = rscale ? rscale[n0 + n] : 1.0f;
        u32x4 o; o.x = pk2(s[0 * 33] * sc, s[1 * 33] * sc); o.y = pk2(s[2 * 33] * sc, s[3 * 33] * sc); o.z = pk2(s[4 * 33] * sc, s[5 * 33] * sc); o.w = pk2(s[6 * 33] * sc, s[7 * 33] * sc);
        *(u32x4*)(WT + (size_t)(n0 + n) * ldk + k0 + 8 * c) = o; }
    asm volatile("s_waitcnt lgkmcnt(0)" ::: "memory");
}
struct XJob { const float* W; int K, N; bf16_t* WT; int ldk; const float* rscale; int items; };
__device__ __forceinline__ XJob xjob(Frame& F, const Args& A, int j) {
    XJob x; x.rscale = nullptr; unsigned char* ws = F.ws;
    if (j < 2)       { x.W = A.in[8] + (size_t)j * 1024 * 1024; x.K = 1024; x.N = 1024; x.WT = (bf16_t*)(ws + WS_WFT) + (size_t)j * 1024 * 1024; }
    else if (j < 6)  { const int g = j - 2; x.W = A.in[9] + (size_t)g * 256 * 256; x.K = 256; x.N = 256; x.WT = (bf16_t*)(ws + WS_WPT) + (size_t)g * 256 * 256; x.rscale = A.in[10] + g * 256; }
    else if (j == 6) { x.W = A.in[11]; x.K = 1024; x.N = 768; x.WT = (bf16_t*)(ws + WS_WDT); }
    else if (j == 7) { x.W = A.in[14]; x.K = 1024; x.N = 576; x.WT = (bf16_t*)(ws + WS_WDT) + (size_t)768 * 1024; }
    else if (j == 8) { x.W = A.in[13]; x.K = 768; x.N = 1536; x.WT = (bf16_t*)(ws + WS_WUQT); }
    else if (j == 9) { x.W = A.in[16]; x.K = 512; x.N = 2048; x.WT = (bf16_t*)(ws + WS_WUKVT); }
    else if (j == 10) { x.W = A.in[17]; x.K = 1024; x.N = 1024; x.WT = (bf16_t*)(ws + WS_WOT); }
    else if (j < 15) { const int l = j - 11; x.W = A.in[18] + (size_t)l * 1024 * DFF2; x.K = 1024; x.N = DFF2; x.WT = (bf16_t*)(ws + WS_WIN) + (size_t)l * DFF2 * 1024; }
    else             { const int l = j - 15; x.W = A.in[21] + (size_t)l * DFF * 1024; x.K = DFF; x.N = 1024; x.WT = (bf16_t*)(ws + WS_WOUT) + (size_t)l * 1024 * DFF; }
    x.ldk = x.K; x.items = (x.K / 64) * (x.N / 32);
    return x;
}
__device__ __forceinline__ void p0_prologue(Frame& F, const Args& A) {
    const int tid = opaque_tid(), lane = tid & 63; (void)tid;
    unsigned char* ws = F.ws;
    { const f32x4* s0 = (const f32x4*)A.in[0]; const f32x4* s1 = (const f32x4*)A.in[1]; f32x4* d = (f32x4*)(ws + WS_X);
      const size_t n0 = (size_t)NP * DM / 4, n1 = (size_t)NS * DM / 4, stride = (size_t)F.G * 512;
      for (size_t i = (size_t)F.vcu * 512 + tid; i < n0 + n1; i += stride) d[i] = (i < n0) ? s0[i] : s1[i - n0]; }
    { const int gt = F.vcu * 512 + tid;
      if (gt < 4 * 16 * 1536) {
          const int layer = gt / (16 * 1536), rem = gt % (16 * 1536), kr = rem / 1536, c4 = rem % 1536;
          const float* W = A.in[6] + (size_t)layer * 1024 * 6144 + (size_t)kr * 64 * 6144 + c4 * 4;
          const float* cc = A.in[5]; const float* c0 = A.in[4]; const float* c1 = A.in[4] + 1024;
          f32x4 a0 = {0.f, 0.f, 0.f, 0.f}, a1 = a0, a2 = a0;
#pragma unroll 8
          for (int k = 0; k < 64; ++k) { const f32x4 w = *(const f32x4*)(W + (size_t)k * 6144); const int kk = kr * 64 + k;
              a0 += w * silu_f(cc[kk]); a1 += w * silu_f(c0[kk]); a2 += w * silu_f(c1[kk]); }
          if (kr == 0) { const f32x4 b = *(const f32x4*)(A.in[7] + (size_t)layer * 6144 + c4 * 4); a0 += b; a1 += b; a2 += b; }
          unsigned long long* M = (unsigned long long*)(ws + WS_CTL + CTL_MOD_OFF) + (size_t)layer * 3 * 6144 + c4 * 4;
#pragma unroll
          for (int e = 0; e < 4; ++e) {
              atomicAdd(M + e, (unsigned long long)(long long)rintf(a0[e] * 4294967296.0f)); atomicAdd(M + 6144 + e, (unsigned long long)(long long)rintf(a1[e] * 4294967296.0f));
              atomicAdd(M + 2 * 6144 + e, (unsigned long long)(long long)rintf(a2[e] * 4294967296.0f)); }
      } }
    { LAS float* scr = (LAS float*)(F.lds + F.wave * 16384);
      int base = 0;
      for (int j = 0; j < 19; ++j) { const XJob x = xjob(F, A, j);
          int it = F.gw - (base % F.ngw); if (it < 0) it += F.ngw;
          for (; it < x.items; it += F.ngw) xpose_item(x.W, x.N, x.WT, x.ldk, x.rscale, scr, it, lane);
          base += x.items; } }
    { u32x4* d = (u32x4*)((bf16_t*)(ws + WS_WDT) + (size_t)1344 * 1024); const size_t n = (size_t)192 * 1024 * 2 / 16;
      for (size_t i = (size_t)F.vcu * 512 + tid; i < n; i += (size_t)F.G * 512) d[i] = (u32x4){0u, 0u, 0u, 0u}; }
    { bf16_t* ds = (bf16_t*)(ws + WS_DFTS); const size_t n = (size_t)SSEQ * 2 * SSEQ / 2; const float sc = 0.022097086912079608f;
      for (size_t i = (size_t)F.vcu * 512 + tid; i < n; i += (size_t)F.G * 512) { const int t = (int)(i / SSEQ); const int k2 = (int)(i % SSEQ) * 2; float v[2];
#pragma unroll
          for (int e = 0; e < 2; ++e) { const int kk = k2 + e; const int s = kk & (SSEQ - 1); const float rev = (float)((t * s) & (SSEQ - 1)) * (1.0f / SSEQ);
              v[e] = (kk < SSEQ) ? __builtin_amdgcn_cosf(rev) * sc : -__builtin_amdgcn_sinf(rev) * sc; }
          ((unsigned*)ds)[i] = pk2(v[0], v[1]); }
      bf16_t* dp = (bf16_t*)(ws + WS_DFTP); const size_t np = (size_t)PSEQ * 2 * PSEQ / 2;
      for (size_t i = (size_t)F.vcu * 512 + tid; i < np; i += (size_t)F.G * 512) { const int t = (int)(i / PSEQ); const int k2 = (int)(i % PSEQ) * 2; float v[2];
#pragma unroll
          for (int e = 0; e < 2; ++e) { const int kk = k2 + e; const int s = kk & (PSEQ - 1); const float rev = (float)((t * s) & (PSEQ - 1)) * (1.0f / PSEQ);
              v[e] = (kk < PSEQ) ? __builtin_amdgcn_cosf(rev) * 0.0625f : -__builtin_amdgcn_sinf(rev) * 0.0625f; }
          ((unsigned*)dp)[i] = pk2(v[0], v[1]); }
      bf16_t* dc = (bf16_t*)(ws + WS_C256); const size_t nc = (size_t)512 * 256 / 2;
      for (size_t i = (size_t)F.vcu * 512 + tid; i < nc; i += (size_t)F.G * 512) { const int r = (int)(i / 128); const int j2 = (int)(i % 128) * 2; float v[2];
#pragma unroll
          for (int e = 0; e < 2; ++e) { const int j = j2 + e; const float rev = (float)(((r & 255) * j) & 255) * (1.0f / 256.0f);
              v[e] = (r < 256) ? __builtin_amdgcn_cosf(rev) * 0.0625f : __builtin_amdgcn_sinf(rev) * 0.0625f; }
          ((unsigned*)dc)[i] = pk2(v[0], v[1]); } }
    { const float* cc = A.in[2]; const float* ck = A.in[3]; bf16_t* CALL = (bf16_t*)(ws + S_CALL); bf16_t* KF = (bf16_t*)(ws + S_KF);
      for (int r = F.gw; r < NSB * PAST; r += F.ngw) { const int b = r / PAST, j = r % PAST; const int krow = NP + b * SKV + j;
#pragma unroll
          for (int q = 0; q < 2; ++q) { const f32x4 v = ((const f32x4*)(cc + (size_t)r * KVRANK))[lane + 64 * q]; u32x2 w; w.x = pk2(v.x, v.y); w.y = pk2(v.z, v.w);
              *((u32x2*)(CALL + (size_t)krow * KVRANK) + lane + 64 * q) = w; }
          const bf16_t xb = (bf16_t)f2bf(ck[(size_t)r * ROPE + lane]);
#pragma unroll
          for (int h = 0; h < NHEAD; ++h) KF[(size_t)krow * 1536 + h * QKD + 128 + lane] = xb; } }
}

namespace att {
constexpr int KVBLK = 64, QBLK = 32;
constexpr int SHM_V = KVBLK * VD * 2, SHM_K = KVBLK * QKD * 2;
constexpr int SHM_ATTN = 2 * SHM_V + 2 * SHM_K + 8 * 64 * 4;
constexpr int LDQ = 1536, LDK = 1536, LDV = 1024, LDO = 1024;
constexpr float THR = 8.f;
#define KSWZ(row, colB) ((row) * 384 + ((colB) ^ (((row) & 7) << 4)))
#define SBAR() __builtin_amdgcn_sched_barrier(0)
__device__ __forceinline__ int crow(int r, int hi) { return (r & 3) + 8 * (r >> 2) + 4 * hi; }
__device__ __forceinline__ void partialSM(f32x16& p0, f32x16& p1, float& m_reg, float& mn, float& alpha) {
  constexpr float C = SM_SCALE * 1.4426950408889634f;
  float pmax = p0[0];
#pragma unroll
  for (int r = 1; r < 16; ++r) pmax = fmaxf(pmax, p0[r]);
#pragma unroll
  for (int r = 0; r < 16; ++r) pmax = fmaxf(pmax, p1[r]);
  { auto rr = __builtin_amdgcn_permlane32_swap(__float_as_uint(pmax), __float_as_uint(pmax), false, false);
    pmax = fmaxf(__uint_as_float(rr[0]), __uint_as_float(rr[1])); }
  if (__builtin_expect(__all(pmax - m_reg <= THR / SM_SCALE), 1)) { mn = m_reg; alpha = 1.f; }
  else { mn = fmaxf(m_reg, pmax); alpha = __builtin_amdgcn_exp2f((m_reg - mn) * C); m_reg = mn; }
  float mnC = -mn * C;
#pragma unroll
  for (int r = 0; r < 16; ++r) p0[r] = fmaf(p0[r], C, mnC);
#pragma unroll
  for (int r = 0; r < 16; ++r) p1[r] = fmaf(p1[r], C, mnC);
#pragma unroll
  for (int r = 0; r < 16; ++r) p0[r] = __builtin_amdgcn_exp2f(p0[r]);
}
__device__ __forceinline__ void finishSM(f32x16& p0, f32x16& p1, float alpha, float& l_reg, bf16x8& pa0, bf16x8& pa1, bf16x8& pa2, bf16x8& pa3) {
#pragma unroll
  for (int r = 0; r < 16; ++r) p1[r] = __builtin_amdgcn_exp2f(p1[r]);
  float ps = 0;
#pragma unroll
  for (int r = 0; r < 16; ++r) ps += p0[r];
#pragma unroll
  for (int r = 0; r < 16; ++r) ps += p1[r];
  { auto rr = __builtin_amdgcn_permlane32_swap(__float_as_uint(ps), __float_as_uint(ps), false, false);
    ps = __uint_as_float(rr[0]) + __uint_as_float(rr[1]); }
  l_reg = l_reg * alpha + ps;
#define PK4(P, BASE, OUT) do { unsigned a0 = cvt_pk_bf16(P[BASE + 0], P[BASE + 1]), a1 = cvt_pk_bf16(P[BASE + 2], P[BASE + 3]);   \
    unsigned b0 = cvt_pk_bf16(P[BASE + 4], P[BASE + 5]), b1 = cvt_pk_bf16(P[BASE + 6], P[BASE + 7]);                              \
    auto r0 = __builtin_amdgcn_permlane32_swap(a0, b0, false, false); auto r1 = __builtin_amdgcn_permlane32_swap(a1, b1, false, false); \
    u32x4 w = {r0[0], r1[0], r0[1], r1[1]}; OUT = *reinterpret_cast<bf16x8*>(&w); } while (0)
  PK4(p0, 0, pa0); PK4(p0, 8, pa1); PK4(p1, 0, pa2); PK4(p1, 8, pa3);
#undef PK4
}
__device__ __forceinline__ void qkt(f32x16& p0, f32x16& p1, const char* Ks, const bf16x8* qr, int r32, int hi) {
  p0 = f32x16{}; p1 = f32x16{};
#pragma unroll
  for (int d0 = 0; d0 < 12; ++d0) { int cb = (d0 * 16 + hi * 8) * 2;
    bf16x8 b0 = *reinterpret_cast<const bf16x8*>(Ks + KSWZ(r32, cb));
    bf16x8 b1 = *reinterpret_cast<const bf16x8*>(Ks + KSWZ(32 + r32, cb));
    p0 = __builtin_amdgcn_mfma_f32_32x32x16_bf16(b0, qr[d0], p0, 0, 0, 0);
    p1 = __builtin_amdgcn_mfma_f32_32x32x16_bf16(b1, qr[d0], p1, 0, 0, 0); }
}
__device__ __forceinline__ int v_st(int k, int c) { const int kk = (k & ~0xC) | ((k & 4) << 1) | ((k & 8) >> 1); return ((kk >> 3) * 4 + (c >> 5)) * 512 + ((kk & 7) * 32 + (c & 31)) * 2; }
__device__ __forceinline__ int v_rd_base(int lane) { return ((lane & 3) << 3) | (((lane >> 2) & 3) << 6) | (((lane >> 4) & 1) << 5) | (((lane >> 5) & 1) << 8); }
constexpr int v_rd_off(int d0, int ks, int half) { return d0 * 512 + ks * 4096 + half * 2048; }
template <int OFF> __device__ __forceinline__ s16x4 tr_read(int vb) {
  s16x4 r; asm volatile("ds_read_b64_tr_b16 %0, %1 offset:%2" : "=&v"(r) : "v"(vb), "i"(OFF) : "memory"); return r;
}
template <int D0> __device__ __forceinline__ void pv_one(f32x16& od, int vb, bf16x8 pa0, bf16x8 pa1, bf16x8 pa2, bf16x8 pa3) {
  const s16x4 l0 = tr_read<v_rd_off(D0, 0, 0)>(vb), h0 = tr_read<v_rd_off(D0, 0, 1)>(vb), l1 = tr_read<v_rd_off(D0, 1, 0)>(vb), h1 = tr_read<v_rd_off(D0, 1, 1)>(vb);
  const s16x4 l2 = tr_read<v_rd_off(D0, 2, 0)>(vb), h2 = tr_read<v_rd_off(D0, 2, 1)>(vb), l3 = tr_read<v_rd_off(D0, 3, 0)>(vb), h3 = tr_read<v_rd_off(D0, 3, 1)>(vb);
  asm volatile("s_waitcnt lgkmcnt(0)" ::: "memory"); SBAR();
#define PK(L, H) (bf16x8){L[0], L[1], L[2], L[3], H[0], H[1], H[2], H[3]}
  od = __builtin_amdgcn_mfma_f32_32x32x16_bf16(pa0, PK(l0, h0), od, 0, 0, 0);
  od = __builtin_amdgcn_mfma_f32_32x32x16_bf16(pa1, PK(l1, h1), od, 0, 0, 0);
  od = __builtin_amdgcn_mfma_f32_32x32x16_bf16(pa2, PK(l2, h2), od, 0, 0, 0);
  od = __builtin_amdgcn_mfma_f32_32x32x16_bf16(pa3, PK(l3, h3), od, 0, 0, 0);
#undef PK
}
__device__ __forceinline__ void pv_d0(f32x16* o, int vb, bf16x8 pa0, bf16x8 pa1, bf16x8 pa2, bf16x8 pa3) {
  pv_one<0>(o[0], vb, pa0, pa1, pa2, pa3); pv_one<1>(o[1], vb, pa0, pa1, pa2, pa3); pv_one<2>(o[2], vb, pa0, pa1, pa2, pa3); pv_one<3>(o[3], vb, pa0, pa1, pa2, pa3);
}
__device__ __forceinline__ void rope_pair(bf16x8& x1, bf16x8& x2, int pos, int hi) {
#pragma unroll
  for (int e = 0; e < 8; ++e) {
    const float inv = __builtin_amdgcn_exp2f(-(float)(hi * 8 + e) * 0.8304820237218407f);
    const float rev = (float)pos * inv * 0.15915494309189535f;
    const float cs = __builtin_amdgcn_cosf(rev), sn = __builtin_amdgcn_sinf(rev);
    const float a = bf2f((unsigned short)x1[e]), b = bf2f((unsigned short)x2[e]);
    x1[e] = (short)f2bf(a * cs - b * sn); x2[e] = (short)f2bf(b * cs + a * sn);
  }
}
__device__ __forceinline__ void attn_unit(const bf16_t* __restrict__ Qb, const bf16_t* __restrict__ Kh, const bf16_t* __restrict__ Vh, bf16_t* __restrict__ Ob, int seq, int rope_t0, char* lds) {
  int tid_ = threadIdx.x; asm volatile("" : "+v"(tid_));
  const int tid = tid_, wid = tid >> 6, lane = tid & 63, r32 = lane & 31, hi = lane >> 5;
  char* V_lds = lds; char* K_lds = lds + 2 * SHM_V;
  float* wsf = (float*)(lds + 2 * SHM_V + 2 * SHM_K) + wid * 64; float* li_l = wsf; float* al_l = wsf + 32;
  float m_reg = -1e30f, l_reg = 0; f32x16 o[4] = {}; bf16x8 qr[12];
  const bf16_t* Qw = Qb + (long)(wid * QBLK + r32) * LDQ + hi * 8;
#pragma unroll
  for (int d0 = 0; d0 < 12; ++d0) qr[d0] = *reinterpret_cast<const bf16x8*>(Qw + d0 * 16);
  if (rope_t0 >= 0) { const int t = rope_t0 + wid * QBLK + r32; rope_pair(qr[8], qr[9], t >> 6, hi); rope_pair(qr[10], qr[11], t & 63, hi); }
  const int sr = tid >> 4, sc = (tid & 15) * 8, vst0 = v_st(sr, sc), vst1 = v_st(32 + sr, sc);
  const int kr0 = tid / 24, kc0 = tid % 24, kr1 = (tid + 512) / 24, kc1 = (tid + 512) % 24, kr2 = (tid + 1024) / 24, kc2 = (tid + 1024) % 24;
  const int vb0 = (int)(uintptr_t)V_lds + v_rd_base(lane);
  bf16x8 s_v0, s_v1, s_k0, s_k1, s_k2;
#define SLOAD(k0) do { s_v0 = *reinterpret_cast<const bf16x8*>(&Vh[(long)((k0) + sr) * LDV + sc]); s_v1 = *reinterpret_cast<const bf16x8*>(&Vh[(long)((k0) + 32 + sr) * LDV + sc]); \
    s_k0 = *reinterpret_cast<const bf16x8*>(&Kh[(long)((k0) + kr0) * LDK + kc0 * 8]); s_k1 = *reinterpret_cast<const bf16x8*>(&Kh[(long)((k0) + kr1) * LDK + kc1 * 8]); \
    s_k2 = *reinterpret_cast<const bf16x8*>(&Kh[(long)((k0) + kr2) * LDK + kc2 * 8]); } while (0)
#define SWRITE(b) do { *(bf16x8*)(V_lds + (b) * SHM_V + vst0) = s_v0; *(bf16x8*)(V_lds + (b) * SHM_V + vst1) = s_v1; \
    *(bf16x8*)(K_lds + (b) * SHM_K + KSWZ(kr0, kc0 * 16)) = s_k0; *(bf16x8*)(K_lds + (b) * SHM_K + KSWZ(kr1, kc1 * 16)) = s_k1; *(bf16x8*)(K_lds + (b) * SHM_K + KSWZ(kr2, kc2 * 16)) = s_k2; } while (0)
#define RESC(a) do { if (__any((a) < 1.f)) { if (hi == 0) al_l[r32] = (a); asm volatile("s_waitcnt lgkmcnt(0)" ::: "memory"); \
    _Pragma("unroll") for (int d = 0; d < 4; ++d) _Pragma("unroll") for (int r = 0; r < 16; ++r) o[d][r] *= al_l[crow(r, hi)]; } } while (0)
  f32x16 p0, p1; float mn, al; bf16x8 pa0, pa1, pa2, pa3; const int NT = seq / KVBLK;
  SLOAD(0); SWRITE(0); __syncthreads();
  for (int j = 0; j < NT; ++j) {
    const int buf = j & 1;
    if (j + 1 < NT) SLOAD((j + 1) * KVBLK);
    SBAR(); qkt(p0, p1, K_lds + buf * SHM_K, qr, r32, hi);
    partialSM(p0, p1, m_reg, mn, al);
    RESC(al);
    finishSM(p0, p1, al, l_reg, pa0, pa1, pa2, pa3); SBAR();
    pv_d0(o, vb0 + buf * SHM_V, pa0, pa1, pa2, pa3);
    if (j + 1 < NT) SWRITE(buf ^ 1);
    __syncthreads();
  }
  if (hi == 0) li_l[r32] = l_reg; asm volatile("s_waitcnt lgkmcnt(0)" ::: "memory");
  float rli[16];
#pragma unroll
  for (int r = 0; r < 16; ++r) rli[r] = __builtin_amdgcn_rcpf(li_l[crow(r, hi)]);
  bf16_t* Ow = Ob + (long)(wid * QBLK) * LDO;
#pragma unroll
  for (int r = 0; r < 16; ++r) { const int orow = crow(r, hi);
#pragma unroll
    for (int d0 = 0; d0 < 4; ++d0) Ow[(long)orow * LDO + d0 * 32 + r32] = (bf16_t)f2bf(o[d0][r] * rli[r]); }
  __syncthreads();
#undef SLOAD
#undef SWRITE
#undef RESC
}
}

constexpr int N_PHASES = 29;
#ifndef DBG_MASK
#define DBG_MASK 0xFFFF
#endif
#define EN(b) ((DBG_MASK >> (b)) & 1)
__device__ __forceinline__ GemmDesc mk_gemm(int kind, int epi, int perm, int total, int lda, int ldb, int hsA, int hsB, int ldc0, int ldc1, int layer, int li) {
    GemmDesc g; g.kind = kind; g.epi = epi; g.perm = perm; g.total = total; g.lda = lda; g.ldb = ldb; g.hsA = hsA; g.hsB = hsB; g.ldc0 = ldc0; g.ldc1 = ldc1; g.layer = layer; g.li = li;
    return g;
}
#define RUN_GEMM(g, GG, cc) gemm_phase(F.lds, g, F.ws, args.in[19], args.in[20], GG, cc)
__device__ __forceinline__ void run_attention(Frame& F) {
    const bf16_t* QF = (const bf16_t*)(F.ws + S_QF); const bf16_t* KF = (const bf16_t*)(F.ws + S_KF); const bf16_t* VF = (const bf16_t*)(F.ws + S_VF); bf16_t* O = (bf16_t*)(F.ws + S_O);
    char* lds = (char*)F.lds;
    const int c = (int)blockIdx.x;
    const bool g256 = (F.G == 256);
    const int nu = g256 ? (c < 128 ? 1 : 2) : (384 - c + F.G - 1) / F.G;
    for (int k = 0; k < nu; ++k) {
        const int uidx = g256 ? (c < 128 ? c : 128 + 2 * (c - 128) + k) : c + k * F.G;
        const bool lat = uidx < 128;
        int tok0, krow0, h, seq, rt0;
        if (lat) { const int b = uidx >> 6, qb = uidx & 7; h = (uidx >> 3) & 7; tok0 = NP + b * SSEQ + qb * 256; krow0 = NP + b * SKV; seq = SKV; rt0 = qb * 256; }
        else { const int v = uidx - 128, b = v >> 3; h = v & 7; tok0 = b * PSEQ; krow0 = tok0; seq = PSEQ; rt0 = -1; }
        att::attn_unit(QF + (size_t)tok0 * 1536 + h * QKD, KF + (size_t)krow0 * 1536 + h * QKD, VF + (size_t)krow0 * 1024 + h * VD, O + (size_t)tok0 * 1024 + h * VD, seq, rt0, lds);
    }
}

__global__ void __launch_bounds__(512, 2) mega_fwd(Args args) {
    extern __shared__ __attribute__((aligned(16))) unsigned char lds_raw[];
    Frame F;
    F.lds = (LAS unsigned char*)lds_raw; F.ws = args.ws; F.out = args.out;
    F.wave = __builtin_amdgcn_readfirstlane(threadIdx.x >> 6);
    F.G = gridDim.x; { const int bx = blockIdx.x; F.vcu = (F.G % 8 == 0) ? (bx % 8) * (F.G / 8) + bx / 8 : bx; }
    F.gw = F.vcu * 8 + F.wave; F.ngw = F.G * 8;
    volatile LAS unsigned* MISC = (volatile LAS unsigned*)(F.lds + MISC_OFF);
    for (int u = threadIdx.x; u < (LDS_BYTES - LDSCTL_OFF) / 4; u += 512) ((LAS unsigned*)(F.lds + LDSCTL_OFF))[u] = 0u;
    __syncthreads();
    unsigned* barw = (unsigned*)(F.ws + WS_CTL) + CW_BAR;
    XcdBarrier bar; bar.bar = barw; bar.x = 0; bar.st = nullptr;
    const int lo = args.ph_lo, hi = args.ph_hi;
    const bool multi = (hi - lo) > 1;
    if (multi) bar = xcd_barrier_post(barw, MISC + 8);
#define IN(k) (lo <= (k) && (k) < hi)
#define SEAM(k) do { if (IN(k) && IN((k) + 1)) xcd_barrier(bar); } while (0)
    int ph = 0;
    const int cx = (int)blockIdx.x;
    if (EN(0) && IN(ph)) { p0_prologue(F, args); } SEAM(ph); ++ph;
    if (EN(1) && IN(ph)) { { const GemmDesc g = mk_gemm(GK_WCOMB, EK_BF16, 1, 64, 1024, 256, 128 * 1024 * 2, 128 * 256 * 2, 1024, 1024, 0, 0); RUN_GEMM(g, F.G, cx); }
                  pass_modulate(F, 0, 0); } SEAM(ph); ++ph;
    for (int layer = 0; layer < 4; ++layer) {
        const int kind = layer % 3;
        if (layer > 0) { if (EN(2) && IN(ph)) pass_modulate(F, layer, 0); SEAM(ph); ++ph; }
        if (kind == 0) {
            if (EN(3) && IN(ph)) { const GemmDesc g = mk_gemm(GK_F1, EK_BF16, 1, 8 * 48, DM, DM, 128 * DM * 2, 128 * DM * 2, 0, 0, layer, layer / 3); RUN_GEMM(g, F.G, cx); } SEAM(ph); ++ph;
            if (EN(4) && IN(ph)) {
                if (F.G >= 128) {
                    if (cx >= 64) { const GemmDesc g = mk_gemm(GK_F2P, EK_XRES, 0, 128, 512, 512, 128 * 512 * 2, 128 * 512 * 2, 0, 0, layer, 0); RUN_GEMM(g, F.G - 64, cx - 64); }
                    else { const GemmDesc g = mk_gemm(GK_F2S, EK_XRES, 0, 64, 4096, 4096, 128 * 4096 * 2, 128 * 4096 * 2, 0, 0, layer, 0); RUN_GEMM(g, 64, cx); }
                } else {
                    { const GemmDesc g = mk_gemm(GK_F2S, EK_XRES, 0, 64, 4096, 4096, 128 * 4096 * 2, 128 * 4096 * 2, 0, 0, layer, 0); RUN_GEMM(g, F.G, cx); }
                    { const GemmDesc g = mk_gemm(GK_F2P, EK_XRES, 0, 128, 512, 512, 128 * 512 * 2, 128 * 512 * 2, 0, 0, layer, 0); RUN_GEMM(g, F.G, cx); }
                } } SEAM(ph); ++ph;
        } else if (kind == 1) {
            if (EN(5) && IN(ph)) pass_pool(F); SEAM(ph); ++ph;
            if (EN(6) && IN(ph)) { const GemmDesc g = mk_gemm(GK_POOL, EK_XRES, 0, 48 * 4, DM, 256, 128 * DM * 2, 128 * 256 * 2, 0, 0, layer, 0); RUN_GEMM(g, F.G, cx); } SEAM(ph); ++ph;
        } else {
            if (EN(7) && IN(ph)) { const GemmDesc g = mk_gemm(GK_A1, EK_F32, 0, 48 * 6, DM, DM, 128 * DM * 2, 128 * DM * 2, NDOWN, NDOWN, layer, 0); RUN_GEMM(g, F.G, cx); } SEAM(ph); ++ph;
            if (EN(8) && IN(ph)) pass_mla_norm(F, args); SEAM(ph); ++ph;
            if (EN(9) && IN(ph)) { { const GemmDesc g = mk_gemm(GK_A3KV, EK_BF16, 1, 50 * 8, KVRANK, KVRANK, 128 * KVRANK * 2, 128 * KVRANK * 2, 1536, 1024, layer, 0); RUN_GEMM(g, F.G, cx); }
                          { const GemmDesc g = mk_gemm(GK_A3Q, EK_BF16, 1, 48 * 6, QRANK, QRANK, 128 * QRANK * 2, 128 * QRANK * 2, 1536, 1536, layer, 0); RUN_GEMM(g, F.G, cx); } } SEAM(ph); ++ph;
            if (EN(10) && IN(ph)) run_attention(F); SEAM(ph); ++ph;
            if (EN(11) && IN(ph)) { const GemmDesc g = mk_gemm(GK_A5, EK_XRES, 0, 48 * 4, DM, DM, 128 * DM * 2, 128 * DM * 2, 0, 0, layer, 0); RUN_GEMM(g, F.G, cx); } SEAM(ph); ++ph;
        }
        if (EN(2) && IN(ph)) pass_modulate(F, layer, 3); SEAM(ph); ++ph;
        if (EN(12) && IN(ph)) { const GemmDesc g = mk_gemm(GK_FFN1, EK_FFN1, 1, 50 * 22, DM, DM, 128 * DM * 2, DFF * DM * 2, 0, 0, layer, 0); RUN_GEMM(g, F.G, cx); } SEAM(ph); ++ph;
        if (EN(13) && IN(ph)) { const GemmDesc g = mk_gemm(GK_FFN2, EK_XRES, 0, 48 * 4, DFF, DFF, 128 * DFF * 2, 128 * DFF * 2, 0, 0, layer, 0); RUN_GEMM(g, F.G, cx); } SEAM(ph); ++ph;
    }
    if (EN(14) && IN(ph)) pass_final(F, args);
#undef IN
#undef SEAM
}

extern "C" void kernel_launch(void* const* d_in, const int* in_sizes, int n_in, void* d_out, int out_size, void* d_ws, size_t ws_size, hipStream_t stream) {
    static int grid = 0;
    if (grid == 0) {
        const long want_out = (long)NTOK * DM + (long)NP * KVRANK + (long)NP * ROPE;
        if (n_in != 23 || in_sizes[0] != NP * DM || in_sizes[1] != NS * DM || (long)out_size != want_out || ws_size < WS_END) {
            fprintf(stderr, "kernel_launch: unexpected shapes: n_in %d in0 %d in1 %d out %d (want %ld) ws %zu (need %zu); nothing launched\n", n_in, n_in > 0 ? in_sizes[0] : -1, n_in > 1 ? in_sizes[1] : -1, out_size, want_out, ws_size, (size_t)WS_END);
            grid = -1; return; }
        int dev = 0, cus = 0;
        if (hipGetDevice(&dev) != hipSuccess || hipDeviceGetAttribute(&cus, hipDeviceAttributeMultiprocessorCount, dev) != hipSuccess) { fprintf(stderr, "kernel_launch: device query failed\n"); grid = -1; return; }
        if (hipFuncSetAttribute((const void*)mega_fwd, hipFuncAttributeMaxDynamicSharedMemorySize, LDS_BYTES) != hipSuccess) { fprintf(stderr, "kernel_launch: hipFuncSetAttribute failed\n"); grid = -1; return; }
        (void)hipGetLastError();
        grid = cus;
    }
    if (grid < 0) return;
    if (hipMemsetAsync((char*)d_ws + WS_CTL, 0, CTL_ZERO_BYTES, stream) != hipSuccess) { fprintf(stderr, "kernel_launch: memset failed\n"); return; }
    Args a{};
    for (int i = 0; i < 23; ++i) a.in[i] = (const float*)d_in[i];
    a.out = (float*)d_out; a.ws = (unsigned char*)d_ws;
#if MK_PER_PHASE
    for (int p = 0; p < N_PHASES; ++p) { a.ph_lo = p; a.ph_hi = p + 1; hipLaunchKernelGGL(mega_fwd, dim3(grid), dim3(512), LDS_BYTES, stream, a); }
#else
    a.ph_lo = 0; a.ph_hi = N_PHASES; hipLaunchKernelGGL(mega_fwd, dim3(grid), dim3(512), LDS_BYTES, stream, a);
#endif
    const hipError_t le = hipPeekAtLastError();
    if (le != hipSuccess) fprintf(stderr, "kernel_launch: launch failed: %s\n", hipGetErrorName(le));
}
```

```cpp
#include <hip/hip_runtime.h>
#include <cstdio>
#include <cstdint>

#ifndef MK_PER_PHASE
#define MK_PER_PHASE 0
#endif

#define LAS __attribute__((address_space(3)))
#define GAS __attribute__((address_space(1)))
typedef unsigned short bf16_t;
typedef short bf16x8 __attribute__((ext_vector_type(8)));
typedef short s16x4 __attribute__((ext_vector_type(4)));
typedef float f32x4 __attribute__((ext_vector_type(4)));
typedef float f32x2 __attribute__((ext_vector_type(2)));
typedef float f32x16 __attribute__((ext_vector_type(16)));
typedef unsigned u32x4 __attribute__((ext_vector_type(4)));
typedef unsigned u32x2 __attribute__((ext_vector_type(2)));

constexpr int DM = 1024, NPB = 32, PSEQ = 256, NSB = 2, SSEQ = 2048, PAST = 256;
constexpr int NP = NPB * PSEQ;
constexpr int NS = NSB * SSEQ;
constexpr int NTOK = NP + NS;
constexpr int DFF = 2816, DFF2 = 5632;
constexpr int QRANK = 768, KVRANK = 512, ROPE = 64, NHEAD = 8, QKD = 192, VD = 128;
constexpr int NDOWN = 1536;
constexpr int KVROWS = NP + NSB * (PAST + SSEQ);
constexpr int SKV = PAST + SSEQ;
constexpr float EPS = 1e-6f;
constexpr float SM_SCALE = 0.07216878364870322f;

constexpr size_t MiB = 1u << 20;
constexpr size_t WS_CTL = 0, CTL_ZERO_BYTES = 1 * MiB;
constexpr size_t WS_X = 1 * MiB;
constexpr size_t WS_H = 49 * MiB;
constexpr size_t WS_WIN = 74 * MiB;
constexpr size_t WS_WOUT = 118 * MiB;
constexpr size_t WS_WFT = 140 * MiB;
constexpr size_t WS_WCS = 144 * MiB;
constexpr size_t WS_DFTS = 152 * MiB;
constexpr size_t WS_DFTP = 168 * MiB;
constexpr size_t WS_WPT = 169 * MiB;
constexpr size_t WS_WDT = 170 * MiB;
constexpr size_t WS_WUQT = 173 * MiB;
constexpr size_t WS_WUKVT = 176 * MiB;
constexpr size_t WS_WOT = 178 * MiB;
constexpr size_t WS_C256 = 180 * MiB;
constexpr size_t WS_S = 182 * MiB;
constexpr size_t WS_END = 372 * MiB;
constexpr size_t S_G = WS_S;
constexpr size_t S_ZF = WS_S;
constexpr size_t S_PL = WS_S;
constexpr size_t S_RAW = WS_S;
constexpr size_t S_QF = WS_S;
constexpr size_t S_KF = WS_S + 72 * MiB;
constexpr size_t S_CQ = WS_S + 110 * MiB;
constexpr size_t S_CALL = WS_S + 128 * MiB;
constexpr size_t S_VF = WS_S + 141 * MiB;
constexpr size_t S_O = WS_S + 166 * MiB;
constexpr int CW_BAR = 4096;
constexpr size_t CTL_MOD_OFF = 64 * 1024;

constexpr int RING_BYTES = 131072;
constexpr int XCH_OFF = RING_BYTES;
constexpr int LDSCTL_OFF = RING_BYTES + 8192, MISC_OFF = LDSCTL_OFF + 320;
constexpr int LDS_BYTES = 147456;

__device__ __forceinline__ unsigned f2bf(float f) { unsigned u = __builtin_bit_cast(unsigned, f); return (u + 0x7fffu + ((u >> 16) & 1u)) >> 16; }
__device__ __forceinline__ unsigned pk2(float lo, float hi) { return f2bf(lo) | (f2bf(hi) << 16); }
__device__ __forceinline__ float bf2f(unsigned short b) { return __builtin_bit_cast(float, ((unsigned)b) << 16); }
__device__ __forceinline__ unsigned cvt_pk_bf16(float lo, float hi) { unsigned r; asm volatile("v_cvt_pk_bf16_f32 %0, %1, %2" : "=v"(r) : "v"(lo), "v"(hi)); return r; }
__device__ __forceinline__ float wave_sum(float v) {
#pragma unroll
    for (int o = 1; o < 64; o <<= 1) v += __shfl_xor(v, o);
    return v;
}
__device__ __forceinline__ float silu_f(float x) { return x / (1.0f + __expf(-x)); }

#define XB_TMO      128
#define XB_XCNT(j)  (256  + 64 * (j))
#define XB_XSUB(j)  (1280 + 64 * (j))
#define XB_XGEN(j)  (2304 + 64 * (j))
#define XB_TOP      3328
#define XB_TOPGEN   3392
#define XCD_BAR_WORDS 3456
#define XB_SPIN_CAP (1u << 20)
__device__ __forceinline__ unsigned xb_ld(unsigned* p)              { return __hip_atomic_load(p, __ATOMIC_RELAXED, __HIP_MEMORY_SCOPE_AGENT); }
__device__ __forceinline__ unsigned xb_add(unsigned* p, unsigned v) { return __hip_atomic_fetch_add(p, v, __ATOMIC_RELAXED, __HIP_MEMORY_SCOPE_AGENT); }
__device__ __forceinline__ unsigned xb_xcc_id() { return (unsigned)__builtin_amdgcn_s_getreg((3 << 11) | 20) & 0xFu; }
#define XB_SPIN(cond, bar) do { unsigned _sp = 0; while (cond) { __builtin_amdgcn_s_sleep(1); \
    if ((++_sp & 255u) == 0u) { if (xb_ld(&(bar)[XB_TMO])) break; if (_sp > XB_SPIN_CAP) { atomicAdd(&(bar)[XB_TMO], 1u); break; } } } } while (0)
struct XcdBarrier { unsigned* bar; unsigned x; volatile LAS unsigned* st; };
__device__ __forceinline__ XcdBarrier xcd_barrier_post(unsigned* bar, volatile LAS unsigned* st) {
    XcdBarrier b; b.bar = bar; b.x = xb_xcc_id(); b.st = st;
    if (threadIdx.x == 0) (void)xb_add(&bar[XB_XCNT(b.x)], 1u);
    return b;
}
__device__ __forceinline__ void xcd_barrier_complete(unsigned* bar, unsigned x, unsigned& nloc, unsigned& nx) {
    const unsigned G = gridDim.x * gridDim.y * gridDim.z;
    unsigned sum, cnt, mine, sp = 0u;
    for (;;) {
        sum = 0u; cnt = 0u; mine = 0u;
#pragma unroll
        for (unsigned j = 0; j < 16; ++j) { const unsigned c = xb_ld(&bar[XB_XCNT(j)]); sum += c; cnt += (c > 0u) ? 1u : 0u; mine = (j == x) ? c : mine; }
        if (sum == G) break;
        __builtin_amdgcn_s_sleep(1);
        if ((++sp & 255u) == 0u) { if (xb_ld(&bar[XB_TMO])) break; if (sp > XB_SPIN_CAP) { atomicAdd(&bar[XB_TMO], 1u); break; } }
    }
    nloc = mine > 0u ? mine : 1u; nx = cnt > 0u ? cnt : 1u;
}
__device__ __forceinline__ void xcd_barrier(const XcdBarrier& b) {
    asm volatile("s_waitcnt vmcnt(0)" ::: "memory");
    __syncthreads();
    if (threadIdx.x == 0) {
        unsigned* bar = b.bar;
        __builtin_amdgcn_s_waitcnt(0);
        unsigned nloc = b.st[0], nx = b.st[1];
        if (nloc == 0u) { xcd_barrier_complete(bar, b.x, nloc, nx); b.st[0] = nloc; b.st[1] = nx; }
        const unsigned old = xb_add(&bar[XB_XSUB(b.x)], 1u);
        const unsigned gen = old / nloc;
        if (old + 1u == (gen + 1u) * nloc) {
            __builtin_amdgcn_fence(__ATOMIC_RELEASE, "agent");
            asm volatile("s_waitcnt vmcnt(0)" ::: "memory");
            const unsigned og = xb_add(&bar[XB_TOP], 1u);
            const unsigned tg = og / nx;
            if (og + 1u == (tg + 1u) * nx) xb_add(&bar[XB_TOPGEN], 1u);
            else XB_SPIN(xb_ld(&bar[XB_TOPGEN]) == tg, bar);
            __builtin_amdgcn_fence(__ATOMIC_ACQUIRE, "agent");
            xb_add(&bar[XB_XGEN(b.x)], 1u);
            asm volatile("s_waitcnt vmcnt(0)" ::: "memory");
        } else {
            XB_SPIN(xb_ld(&bar[XB_XGEN(b.x)]) == gen, bar);
            __builtin_amdgcn_fence(__ATOMIC_ACQUIRE, "agent");
            asm volatile("s_waitcnt vmcnt(0)" ::: "memory");
        }
    }
    __syncthreads();
}

namespace pg8 {
constexpr int BM = 256, BK = 64, HALF = 128, HTB = HALF * BK * 2, STAGE_BYTES = 8 * HTB, NXCD = 8, WGM = 8;
__host__ __device__ __forceinline__ int lds_byte(int r, int c) { const int st = (r >> 4) * 2 + (c >> 5), rr = r & 15, cc = c & 31, ob = rr * 64 + cc * 2; return st * 1024 + (ob ^ (((ob >> 9) & 1) << 5)); }
__host__ __device__ __forceinline__ void stage_rc(int b, int& R, int& C) { const int st = b / 1024, sb = b % 1024, swz = sb ^ (((sb >> 9) & 1) << 5); R = (st >> 1) * 16 + swz / 64; C = (st & 1) * 32 + (swz % 64) / 2; }
__host__ __device__ __forceinline__ int perm32(int rho) { const int n = rho >> 4, i = rho & 15; return 8 * (i >> 2) + 4 * n + (i & 3); }
}

enum GemmKind { GK_FFN1 = 0, GK_FFN2, GK_F1, GK_F2S, GK_F2P, GK_POOL, GK_A1, GK_A3Q, GK_A3KV, GK_A5, GK_WCOMB };
enum EpiKind { EK_XRES = 0, EK_BF16, EK_F32, EK_FFN1 };

typedef long long modacc_t;
struct EUnit {
    char* o0; char* o1;
    const float* aux;
    const modacc_t* gate;
    const float* aux2;
    int i0, i1, i2, i3;
};
struct GemmDesc {
    int kind, epi, perm;
    int total, lda, ldb;
    int hsA, hsB;
    int ldc0, ldc1;
    int layer, li;
};

struct Args { const float* in[23]; float* out; unsigned char* ws; int ph_lo, ph_hi; };

__device__ __forceinline__ void grid_order(int L, int nM, int nN, int& pm, int& pn) {
    const int nwg = nM * nN; int wgid = L;
    { const int q = nwg / pg8::NXCD, r = nwg % pg8::NXCD, xcd = wgid % pg8::NXCD, off = wgid / pg8::NXCD; wgid = (xcd < r ? xcd * (q + 1) : r * (q + 1) + (xcd - r) * q) + off; }
    const int nig = pg8::WGM * nN, gid = wgid / nig, fm = gid * pg8::WGM, gsz = (nM - fm) < pg8::WGM ? (nM - fm) : pg8::WGM;
    pm = fm + ((wgid % nig) % gsz); pn = (wgid % nig) / gsz;
}
__device__ __forceinline__ const modacc_t* mod_vec(const unsigned char* ws, int layer, int tok, int which) {
    const int cond = tok < NP ? 0 : 1 + (tok - NP) / SSEQ;
    return (const modacc_t*)(ws + WS_CTL + CTL_MOD_OFF) + ((size_t)(layer * 3 + cond) * 6144 + which * 1024);
}
typedef long long i64x2 __attribute__((ext_vector_type(2)));
__device__ __forceinline__ f32x4 mod_ld4(const modacc_t* p) {
    const i64x2 a = *(const i64x2*)p, b = *(const i64x2*)(p + 2);
    f32x4 r; r.x = (float)a.x * 2.3283064365386963e-10f; r.y = (float)a.y * 2.3283064365386963e-10f; r.z = (float)b.x * 2.3283064365386963e-10f; r.w = (float)b.y * 2.3283064365386963e-10f;
    return r;
}
__device__ __forceinline__ void ffn1_tile(int pm, int& tok0, int& p0, int& T, int& rlo, int& rhi) {
    if (pm < 32) { tok0 = pm * 256; p0 = 0; T = 256; rlo = 0; rhi = 256; }
    else { const int j9 = pm - 32, b = j9 / 9, j = j9 % 9; p0 = 254 * j - 1; tok0 = NP + b * SSEQ + p0; T = SSEQ; rlo = 1; rhi = (SSEQ - p0) < 255 ? (SSEQ - p0) : 255; }
}

__device__ __forceinline__ void get_ab(const GemmDesc& g, const unsigned char* ws, int L, const char*& A, const char*& B, int& nt) {
    switch (g.kind) {
    case GK_FFN1: { int pm, pn; grid_order(L, 50, 22, pm, pn); int tok0, p0, T, rlo, rhi; ffn1_tile(pm, tok0, p0, T, rlo, rhi);
        A = (const char*)(ws + WS_H) + (long)tok0 * DM * 2;
        B = (const char*)(ws + WS_WIN) + ((size_t)g.layer * DFF2 + 128 * pn) * DM * 2; nt = 16; } break;
    case GK_FFN2: { int pm, pn; grid_order(L, 48, 4, pm, pn);
        A = (const char*)(ws + S_G) + (size_t)pm * 256 * DFF * 2;
        B = (const char*)(ws + WS_WOUT) + ((size_t)g.layer * DM + pn * 256) * DFF * 2; nt = 44; } break;
    case GK_F1: { int pm, pn; grid_order(L, 8, 48, pm, pn);
        A = (const char*)(ws + WS_WCS) + ((size_t)g.li * 2048 + pm * 256) * DM * 2;
        B = (const char*)(ws + WS_H) + (size_t)pn * 256 * DM * 2; nt = 16; } break;
    case GK_F2S: { const int b = L / 32, mt = (L % 32) / 4, pn = L % 4;
        A = (const char*)(ws + WS_DFTS) + (size_t)mt * 256 * 4096 * 2;
        B = (const char*)(ws + S_ZF) + (size_t)NPB * 1024 * 512 * 2 + ((size_t)b * 1024 + pn * 256) * 4096 * 2; nt = 64; } break;
    case GK_F2P: { const int b = L / 4, pn = L % 4;
        A = (const char*)(ws + WS_DFTP);
        B = (const char*)(ws + S_ZF) + ((size_t)b * 1024 + pn * 256) * 512 * 2; nt = 8; } break;
    case GK_POOL: { int pm, pn; grid_order(L, 48, 4, pm, pn);
        A = (const char*)(ws + S_PL) + ((size_t)pm * 256 * DM + pn * 256) * 2;
        B = (const char*)(ws + WS_WPT) + (size_t)pn * 256 * 256 * 2; nt = 4; } break;
    case GK_A1: { int pm, pn; grid_order(L, 48, 6, pm, pn);
        A = (const char*)(ws + WS_H) + (size_t)pm * 256 * DM * 2;
        B = (const char*)(ws + WS_WDT) + (size_t)pn * 256 * DM * 2; nt = 16; } break;
    case GK_A3Q: { int pm, pn; grid_order(L, 48, 6, pm, pn);
        A = (const char*)(ws + S_CQ) + (size_t)pm * 256 * QRANK * 2;
        B = (const char*)(ws + WS_WUQT) + (size_t)pn * 256 * QRANK * 2; nt = 12; } break;
    case GK_A3KV: { int pm, pn; grid_order(L, 50, 8, pm, pn);
        A = (const char*)(ws + S_CALL) + (size_t)pm * 256 * KVRANK * 2;
        B = (const char*)(ws + WS_WUKVT) + (size_t)pn * 256 * KVRANK * 2; nt = 8; } break;
    case GK_A5: { int pm, pn; grid_order(L, 48, 4, pm, pn);
        A = (const char*)(ws + S_O) + (size_t)pm * 256 * DM * 2;
        B = (const char*)(ws + WS_WOT) + (size_t)pn * 256 * DM * 2; nt = 16; } break;
    default: {
        const int l = L / 32, r = L % 32, gq = r / 8, pm = (r % 8) / 2, pn = r % 2;
        A = (const char*)(ws + WS_WFT) + ((size_t)l * 1024 * 1024 + (size_t)pm * 256 * 1024 + gq * 256) * 2;
        B = (const char*)(ws + WS_C256) + (size_t)pn * 256 * 256 * 2; nt = 4; } break;
    }
}
__device__ __forceinline__ void get_epi(const GemmDesc& g, unsigned char* ws, const float* cw, const float* cb, int L, EUnit& u) {
    u.aux = nullptr; u.aux2 = nullptr; u.gate = nullptr; u.o1 = nullptr; u.i0 = u.i1 = u.i2 = u.i3 = 0;
    switch (g.kind) {
    case GK_FFN1: { int pm, pn; grid_order(L, 50, 22, pm, pn); int tok0, p0, T, rlo, rhi; ffn1_tile(pm, tok0, p0, T, rlo, rhi);
        u.o0 = (char*)(ws + S_G) + ((long)tok0 * DFF + 128 * pn) * 2;
        u.aux = cw + (size_t)g.layer * 3 * DFF2 + 128 * pn;
        u.aux2 = cb + (size_t)g.layer * DFF2 + 128 * pn;
        u.i0 = p0; u.i1 = T; u.i2 = rlo; u.i3 = rhi; } break;
    case GK_FFN2: { int pm, pn; grid_order(L, 48, 4, pm, pn);
        u.o0 = (char*)(ws + WS_X) + ((size_t)pm * 256 * DM + pn * 256) * 4; u.gate = mod_vec(ws, g.layer, pm * 256, 5) + pn * 256; } break;
    case GK_F1: { int pm, pn; grid_order(L, 8, 48, pm, pn);
        const int part = pm >> 2, n0 = (pm & 3) * 256, tok0 = pn * 256;
        char* zb; int T, s0;
        if (tok0 < NP) { T = PSEQ; s0 = 0; zb = (char*)(ws + S_ZF) + (size_t)(tok0 / PSEQ) * 1024 * 512 * 2; }
        else { T = SSEQ; const int b = (tok0 - NP) / SSEQ; s0 = (tok0 - NP) % SSEQ; zb = (char*)(ws + S_ZF) + (size_t)NPB * 1024 * 512 * 2 + (size_t)b * 1024 * 4096 * 2; }
        u.o0 = zb + ((size_t)n0 * 2 * T + part * T + s0) * 2; u.o1 = u.o0 + 128 * 2; u.i0 = 2 * T; } break;
    case GK_F2S: { const int b = L / 32, mt = (L % 32) / 4, pn = L % 4; const int tok0 = NP + b * SSEQ + mt * 256;
        u.o0 = (char*)(ws + WS_X) + ((size_t)tok0 * DM + pn * 256) * 4; u.gate = mod_vec(ws, g.layer, tok0, 2) + pn * 256; } break;
    case GK_F2P: { const int b = L / 4, pn = L % 4; const int tok0 = b * PSEQ;
        u.o0 = (char*)(ws + WS_X) + ((size_t)tok0 * DM + pn * 256) * 4; u.gate = mod_vec(ws, g.layer, tok0, 2) + pn * 256; } break;
    case GK_POOL: { int pm, pn; grid_order(L, 48, 4, pm, pn);
        u.o0 = (char*)(ws + WS_X) + ((size_t)pm * 256 * DM + pn * 256) * 4; u.gate = mod_vec(ws, g.layer, pm * 256, 2) + pn * 256; } break;
    case GK_A1: { int pm, pn; grid_order(L, 48, 6, pm, pn);
        u.o0 = (char*)(ws + S_RAW) + ((size_t)pm * 256 * NDOWN + pn * 256) * 4; } break;
    case GK_A3Q: { int pm, pn; grid_order(L, 48, 6, pm, pn);
        u.o0 = (char*)(ws + S_QF) + ((size_t)pm * 256 * 1536 + pn * 256) * 2; u.o1 = u.o0 + 128 * 2; } break;
    case GK_A3KV: { int pm, pn; grid_order(L, 50, 8, pm, pn);
        u.o0 = (char*)(ws + S_KF) + ((size_t)pm * 256 * 1536 + pn * QKD) * 2;
        u.o1 = (char*)(ws + S_VF) + ((size_t)pm * 256 * 1024 + pn * VD) * 2; } break;
    case GK_A5: { int pm, pn; grid_order(L, 48, 4, pm, pn);
        u.o0 = (char*)(ws + WS_X) + ((size_t)pm * 256 * DM + pn * 256) * 4; u.gate = mod_vec(ws, g.layer, pm * 256, 2) + pn * 256; } break;
    default: { const int l = L / 32, r = L % 32, gq = r / 8, pm = (r % 8) / 2, pn = r % 2;
        u.o0 = (char*)(ws + WS_WCS) + (((size_t)l * 2048 + pn * 1024 + pm * 256) * 1024 + gq * 256) * 2; u.o1 = u.o0 + 128 * 2; } break;
    }
}

typedef f32x4 Acc[2][2][4][2];

__device__ __forceinline__ void epi_xres(const Acc& acc, const EUnit& u, int wr, int wc, int fr, int fq) {
    float* X0 = (float*)u.o0; const int cb = wc * 32 + 4 * fq;
    f32x4 gv[2][2];
#pragma unroll
    for (int bj = 0; bj < 2; ++bj)
#pragma unroll
        for (int n = 0; n < 2; ++n) gv[bj][n] = mod_ld4(u.gate + cb + bj * 128 + n * 16);
#pragma unroll
    for (int ai = 0; ai < 2; ++ai)
#pragma unroll
        for (int m = 0; m < 4; ++m) { float* rowp = X0 + (size_t)(ai * 128 + wr * 64 + m * 16 + fr) * DM + cb;
#pragma unroll
            for (int bj = 0; bj < 2; ++bj)
#pragma unroll
                for (int n = 0; n < 2; ++n) { f32x4* p = (f32x4*)(rowp + bj * 128 + n * 16); const f32x4 xv = *p; *p = xv + gv[bj][n] * acc[ai][bj][m][n]; } }
}
__device__ __forceinline__ void epi_f32(const Acc& acc, const EUnit& u, int ldc, int wr, int wc, int fr, int fq) {
    float* C0 = (float*)u.o0; const int cb = wc * 32 + 4 * fq;
#pragma unroll
    for (int ai = 0; ai < 2; ++ai)
#pragma unroll
        for (int m = 0; m < 4; ++m) { float* rowp = C0 + (size_t)(ai * 128 + wr * 64 + m * 16 + fr) * ldc + cb;
#pragma unroll
            for (int bj = 0; bj < 2; ++bj)
#pragma unroll
                for (int n = 0; n < 2; ++n) *(f32x4*)(rowp + bj * 128 + n * 16) = acc[ai][bj][m][n]; }
}
__device__ __forceinline__ void epi_bf16(const Acc& acc, const EUnit& u, int ldc0, int ldc1, int wr, int wc, int fr, int fq) {
    const int cb = wc * 32 + 8 * fq;
#pragma unroll
    for (int ai = 0; ai < 2; ++ai)
#pragma unroll
        for (int m = 0; m < 4; ++m) { const int r = ai * 128 + wr * 64 + m * 16 + fr;
#pragma unroll
            for (int bj = 0; bj < 2; ++bj) { bf16_t* dst = (bf16_t*)(bj ? u.o1 : u.o0) + (size_t)r * (bj ? ldc1 : ldc0) + cb;
                const f32x4 v0 = acc[ai][bj][m][0], v1 = acc[ai][bj][m][1];
                u32x4 w; w.x = cvt_pk_bf16(v0[0], v0[1]); w.y = cvt_pk_bf16(v0[2], v0[3]); w.z = cvt_pk_bf16(v1[0], v1[1]); w.w = cvt_pk_bf16(v1[2], v1[3]);
                *(u32x4*)dst = w; } }
}
__device__ __forceinline__ void epi_ffn1(Acc& acc, const EUnit& u, LAS unsigned char* lds, int wr, int wc, int fr, int fq, int lane) {
    const int p0 = u.i0, T = u.i1, rlo = u.i2, rhi = u.i3;
    if (p0 < 0 || p0 + 256 > T) {
#pragma unroll
        for (int ai = 0; ai < 2; ++ai)
#pragma unroll
            for (int m = 0; m < 4; ++m) { const int p = p0 + ai * 128 + wr * 64 + m * 16 + fr; const bool ok = (p >= 0) && (p < T);
#pragma unroll
                for (int bj = 0; bj < 2; ++bj)
#pragma unroll
                    for (int n = 0; n < 2; ++n) { f32x4 v = acc[ai][bj][m][n]; v[0] = ok ? v[0] : 0.f; v[1] = ok ? v[1] : 0.f; v[2] = ok ? v[2] : 0.f; v[3] = ok ? v[3] : 0.f; acc[ai][bj][m][n] = v; } }
    }
    LAS float* XCH = (LAS float*)(lds + XCH_OFF);
    const int cw8 = wc * 32 + 8 * fq;
    if (fr == 0 || fr == 15) {
        const int e = (fr == 15) ? 1 : 0, mm = (fr == 15) ? 3 : 0;
#pragma unroll
        for (int ai = 0; ai < 2; ++ai)
#pragma unroll
            for (int bj = 0; bj < 2; ++bj)
#pragma unroll
                for (int n = 0; n < 2; ++n) {
                    const f32x4 v = (mm == 3) ? acc[ai][bj][3][n] : acc[ai][bj][0][n];
                    *(LAS f32x4*)(XCH + ((2 * ai + wr) * 2 + e) * 256 + bj * 128 + cw8 + 4 * n) = v; }
    }
    asm volatile("s_waitcnt lgkmcnt(0)" ::: "memory"); __builtin_amdgcn_s_barrier(); asm volatile("" ::: "memory");
    const int srcUp = (lane & 48) | ((lane - 1) & 15), srcDn = (lane & 48) | ((lane + 1) & 15);
    const float* wcv = u.aux; const float* bcv = u.aux2;
    unsigned packed[2][4][4];
#pragma unroll
    for (int n = 0; n < 2; ++n) {
        const int cc = cw8 + 4 * n;
        const f32x4 w0g = *(const f32x4*)(wcv + cc), w1g = *(const f32x4*)(wcv + DFF2 + cc), w2g = *(const f32x4*)(wcv + 2 * DFF2 + cc), bg = *(const f32x4*)(bcv + cc);
        const f32x4 w0v = *(const f32x4*)(wcv + DFF + cc), w1v = *(const f32x4*)(wcv + DFF2 + DFF + cc), w2v = *(const f32x4*)(wcv + 2 * DFF2 + DFF + cc), bv = *(const f32x4*)(bcv + DFF + cc);
#pragma unroll
        for (int ai = 0; ai < 2; ++ai) {
            const int q = 2 * ai + wr;
            f32x4 htop[2], hbot[2];
#pragma unroll
            for (int bj = 0; bj < 2; ++bj) {
                htop[bj] = (q > 0) ? *(const LAS f32x4*)(XCH + ((q - 1) * 2 + 1) * 256 + bj * 128 + cc) : (f32x4){0.f, 0.f, 0.f, 0.f};
                hbot[bj] = (q < 3) ? *(const LAS f32x4*)(XCH + ((q + 1) * 2 + 0) * 256 + bj * 128 + cc) : (f32x4){0.f, 0.f, 0.f, 0.f};
            }
#pragma unroll
            for (int m = 0; m < 4; ++m) {
                f32x4 uu[2];
#pragma unroll
                for (int bj = 0; bj < 2; ++bj) {
                    const f32x4 cur = acc[ai][bj][m][n];
                    const f32x4 prv = (m > 0) ? acc[ai][bj][m > 0 ? m - 1 : 0][n] : cur;
                    const f32x4 nxt = (m < 3) ? acc[ai][bj][m < 3 ? m + 1 : 3][n] : cur;
                    f32x4 up, dn;
#pragma unroll
                    for (int e = 0; e < 4; ++e) {
                        const float su = (fr == 15) ? prv[e] : cur[e];
                        const float sd = (fr == 0) ? nxt[e] : cur[e];
                        up[e] = __shfl(su, srcUp); dn[e] = __shfl(sd, srcDn);
                    }
                    if (m == 0) { up[0] = (fr == 0) ? htop[bj][0] : up[0]; up[1] = (fr == 0) ? htop[bj][1] : up[1]; up[2] = (fr == 0) ? htop[bj][2] : up[2]; up[3] = (fr == 0) ? htop[bj][3] : up[3]; }
                    if (m == 3) { dn[0] = (fr == 15) ? hbot[bj][0] : dn[0]; dn[1] = (fr == 15) ? hbot[bj][1] : dn[1]; dn[2] = (fr == 15) ? hbot[bj][2] : dn[2]; dn[3] = (fr == 15) ? hbot[bj][3] : dn[3]; }
                    const f32x4 w0 = bj ? w0v : w0g, w1 = bj ? w1v : w1g, w2 = bj ? w2v : w2g, bb = bj ? bv : bg;
                    uu[bj] = w0 * up + w1 * cur + w2 * dn + bb;
                }
                f32x4 o;
#pragma unroll
                for (int e = 0; e < 4; ++e) { const float gt = uu[0][e]; o[e] = gt * __builtin_amdgcn_rcpf(1.0f + __expf(-gt)) * uu[1][e]; }
                packed[ai][m][2 * n] = cvt_pk_bf16(o[0], o[1]); packed[ai][m][2 * n + 1] = cvt_pk_bf16(o[2], o[3]);
            }
        }
    }
    bf16_t* G0 = (bf16_t*)u.o0;
#pragma unroll
    for (int ai = 0; ai < 2; ++ai)
#pragma unroll
        for (int m = 0; m < 4; ++m) { const int r = ai * 128 + wr * 64 + m * 16 + fr;
            if (r >= rlo && r < rhi) { u32x4 w; w.x = packed[ai][m][0]; w.y = packed[ai][m][1]; w.z = packed[ai][m][2]; w.w = packed[ai][m][3];
                *(u32x4*)(G0 + (long)r * DFF + cw8) = w; } }
}

__device__ __forceinline__ void gemm_phase(LAS unsigned char* lds, const GemmDesc& g, unsigned char* ws, const float* cw, const float* cb, int G, int c) {
    using namespace pg8;
    int tid_ = threadIdx.x; asm volatile("" : "+v"(tid_));
    const int tid = tid_, wid = __builtin_amdgcn_readfirstlane(tid >> 6), lane = tid & 63, wr = wid >> 2, wc = wid & 3, fr = lane & 15, fq = lane >> 4;
    if (c >= g.total) return;
    unsigned voffA[2], voffB[2];
#pragma unroll
    for (int i = 0; i < 2; ++i) { int R, C; stage_rc(tid * 16 + i * 8192, R, C); const int Rb = g.perm ? ((R & ~31) + perm32(R & 31)) : R;
        voffA[i] = (unsigned)(R * g.lda + C) * 2u; voffB[i] = (unsigned)(Rb * g.ldb + C) * 2u; }
    const size_t kstep = (size_t)(BK * 2);
    const size_t hsA = (size_t)g.hsA, hsB = (size_t)g.hsB;
    const unsigned ldsw = (unsigned)wid * 1024u;
    const int aoff = lds_byte(wr * 64 + fr, fq * 8), boff = lds_byte(wc * 32 + fr, fq * 8);
#define PG8_SA(b, h) (((b) * 2 + (h)) * HTB)
#define PG8_SB(b, h) ((4 + (b) * 2 + (h)) * HTB)
#define PG8_STAGE(bufoff, gbase, voff) do { _Pragma("unroll") for (int _i = 0; _i < 2; ++_i) \
        __builtin_amdgcn_global_load_lds((const unsigned*)((const char*)(gbase) + (voff)[_i]), (LAS unsigned*)(lds + (bufoff) + ldsw + _i * 8192), 16, 0, 0); } while (0)
#define PG8_LDA(dst, b, h) do { _Pragma("unroll") for (int m = 0; m < 4; ++m) _Pragma("unroll") for (int k = 0; k < 2; ++k) dst[m][k] = *(const LAS bf16x8*)(lds + PG8_SA(b, h) + aoff + m * 2048 + k * 1024); } while (0)
#define PG8_LDB(dst, b, h) do { _Pragma("unroll") for (int n = 0; n < 2; ++n) _Pragma("unroll") for (int k = 0; k < 2; ++k) dst[n][k] = *(const LAS bf16x8*)(lds + PG8_SB(b, h) + boff + n * 2048 + k * 1024); } while (0)
#define PG8_MMA(ai, bj, At, Bt) do { __builtin_amdgcn_s_setprio(1); _Pragma("unroll") for (int m = 0; m < 4; ++m) _Pragma("unroll") for (int n = 0; n < 2; ++n) _Pragma("unroll") for (int k = 0; k < 2; ++k) \
        acc[ai][bj][m][n] = __builtin_amdgcn_mfma_f32_16x16x32_bf16(Bt[n][k], At[m][k], acc[ai][bj][m][n], 0, 0, 0); __builtin_amdgcn_s_setprio(0); } while (0)
#define PG8_WAIT_V(n) asm volatile("s_waitcnt vmcnt(" #n ")" ::: "memory")
#define PG8_WAIT_L(n) asm volatile("s_waitcnt lgkmcnt(" #n ")" ::: "memory")
#define PG8_BAR __builtin_amdgcn_s_barrier()
#define PG8_SCHED __builtin_amdgcn_sched_barrier(0)
    int L = c, nt;
    const char* cA; const char* cB;
    get_ab(g, ws, L, cA, cB, nt);
    Acc acc;
#pragma unroll
    for (int a = 0; a < 2; ++a)
#pragma unroll
        for (int b = 0; b < 2; ++b)
#pragma unroll
            for (int m = 0; m < 4; ++m)
#pragma unroll
                for (int n = 0; n < 2; ++n) acc[a][b][m][n] = (f32x4){0.f, 0.f, 0.f, 0.f};
    bf16x8 At[4][2], B0[2][2], B1[2][2];
    PG8_STAGE(PG8_SB(0, 0), cB, voffB); PG8_STAGE(PG8_SB(0, 1), cB + hsB, voffB); PG8_STAGE(PG8_SA(0, 0), cA, voffA); PG8_STAGE(PG8_SA(0, 1), cA + hsA, voffA);
    if (wr == 1) PG8_BAR;
    PG8_WAIT_V(2); PG8_BAR;
    PG8_STAGE(PG8_SB(1, 0), cB + kstep, voffB); PG8_STAGE(PG8_SA(1, 0), cA + kstep, voffA); PG8_STAGE(PG8_SB(1, 1), cB + hsB + kstep, voffB);
    PG8_WAIT_V(6); PG8_BAR;
    for (;;) {
        const bool has_next = (L + G) < g.total;
        const char* nA = cA; const char* nB = cB; int nnt = nt;
        if (has_next) get_ab(g, ws, L + G, nA, nB, nnt);
        for (int t = 0; t < nt; t += 2) {
            const bool last = (t == nt - 2);
            const char* a1 = cA + (size_t)(t + 1) * kstep;
            const char* a2 = last ? nA : cA + (size_t)(t + 2) * kstep; const char* b2 = last ? nB : cB + (size_t)(t + 2) * kstep;
            const char* a3 = a2 + kstep; const char* b3 = b2 + kstep;
            PG8_LDB(B0, 0, 0); PG8_LDB(B1, 0, 1); PG8_SCHED; PG8_LDA(At, 0, 0); PG8_STAGE(PG8_SA(1, 1), a1 + hsA, voffA);
            PG8_WAIT_V(8); PG8_WAIT_L(0); PG8_BAR; PG8_MMA(0, 0, At, B0); PG8_MMA(0, 1, At, B1); PG8_BAR; PG8_SCHED;
            PG8_LDA(At, 0, 1); PG8_STAGE(PG8_SB(0, 0), b2, voffB); PG8_STAGE(PG8_SB(0, 1), b2 + hsB, voffB); PG8_STAGE(PG8_SA(0, 0), a2, voffA);
            PG8_WAIT_V(8); PG8_WAIT_L(0); PG8_BAR; PG8_MMA(1, 0, At, B0); PG8_MMA(1, 1, At, B1); PG8_BAR; PG8_SCHED;
            PG8_LDB(B0, 1, 0); PG8_LDB(B1, 1, 1); PG8_SCHED; PG8_LDA(At, 1, 0); PG8_STAGE(PG8_SA(0, 1), a2 + hsA, voffA);
            PG8_WAIT_V(8); PG8_WAIT_L(0); PG8_BAR; PG8_MMA(0, 0, At, B0); PG8_MMA(0, 1, At, B1); PG8_BAR; PG8_SCHED;
            PG8_LDA(At, 1, 1); PG8_STAGE(PG8_SB(1, 0), b3, voffB); PG8_STAGE(PG8_SB(1, 1), b3 + hsB, voffB); PG8_STAGE(PG8_SA(1, 0), a3, voffA);
            PG8_WAIT_V(8); PG8_WAIT_L(0); PG8_BAR; PG8_MMA(1, 0, At, B0); PG8_MMA(1, 1, At, B1); PG8_BAR; PG8_SCHED;
        }
        if (wr == 0) PG8_BAR;
        { EUnit eu; get_epi(g, ws, cw, cb, L, eu);
          int efr = fr, efq = fq, elane = lane; asm volatile("" : "+v"(efr), "+v"(efq), "+v"(elane));
          switch (g.epi) {
          case EK_XRES: epi_xres(acc, eu, wr, wc, efr, efq); break;
          case EK_BF16: epi_bf16(acc, eu, g.kind == GK_F1 ? eu.i0 : g.ldc0, g.kind == GK_F1 ? eu.i0 : g.ldc1, wr, wc, efr, efq); break;
          case EK_F32: epi_f32(acc, eu, g.ldc0, wr, wc, efr, efq); break;
          default: epi_ffn1(acc, eu, lds, wr, wc, efr, efq, elane); break;
          } }
        if (!has_next) break;
#pragma unroll
        for (int a = 0; a < 2; ++a)
#pragma unroll
            for (int b = 0; b < 2; ++b)
#pragma unroll
                for (int m = 0; m < 4; ++m)
#pragma unroll
                    for (int n = 0; n < 2; ++n) acc[a][b][m][n] = (f32x4){0.f, 0.f, 0.f, 0.f};
        L += G; cA = nA; cB = nB; nt = nnt;
        if (wr == 1) PG8_BAR;
    }
    PG8_WAIT_V(0);
    PG8_BAR;
#undef PG8_SA
#undef PG8_SB
#undef PG8_STAGE
#undef PG8_LDA
#undef PG8_LDB
#undef PG8_MMA
#undef PG8_WAIT_V
#undef PG8_WAIT_L
#undef PG8_BAR
#undef PG8_SCHED
}

__device__ __forceinline__ int opaque_tid() { int t = threadIdx.x; asm volatile("" : "+v"(t)); return t; }
struct Frame {
    LAS unsigned char* lds; unsigned char* ws; float* out;
    int wave, vcu, G, gw, ngw;
};

__device__ __forceinline__ void pass_modulate(Frame& F, int layer, int which) {
    const int tid = opaque_tid(), lane = tid & 63; (void)tid;
    const float* X = (const float*)(F.ws + WS_X); bf16_t* H = (bf16_t*)(F.ws + WS_H);
    for (int tok = F.gw; tok < NTOK; tok += F.ngw) {
        const f32x4* xr = (const f32x4*)(X + (size_t)tok * DM) + lane;
        f32x4 v[4]; float s = 0.f;
#pragma unroll
        for (int j = 0; j < 4; ++j) { v[j] = xr[64 * j]; s += (v[j].x * v[j].x + v[j].y * v[j].y) + (v[j].z * v[j].z + v[j].w * v[j].w); }
        const float rstd = 1.0f / sqrtf(wave_sum(s) * (1.0f / DM) + EPS);
        const modacc_t* sh = mod_vec(F.ws, layer, tok, which) + 4 * lane;
        const modacc_t* sc = mod_vec(F.ws, layer, tok, which + 1) + 4 * lane;
        u32x2* o8 = (u32x2*)(H + (size_t)tok * DM) + lane;
#pragma unroll
        for (int j = 0; j < 4; ++j) { const f32x4 a = mod_ld4(sh + 256 * j), b = mod_ld4(sc + 256 * j); const f32x4 h = v[j] * rstd * (b + 1.0f) + a;
            u32x2 w; w.x = pk2(h.x, h.y); w.y = pk2(h.z, h.w); o8[64 * j] = w; }
    }
}
__device__ __forceinline__ void pass_final(Frame& F, const Args& A) {
    const int tid = opaque_tid(), lane = tid & 63; (void)tid;
    const float* X = (const float*)(F.ws + WS_X); const float* gf = A.in[22];
    for (int tok = F.gw; tok < NTOK; tok += F.ngw) {
        const f32x4* xr = (const f32x4*)(X + (size_t)tok * DM) + lane;
        f32x4 v[4]; float s = 0.f;
#pragma unroll
        for (int j = 0; j < 4; ++j) { v[j] = xr[64 * j]; s += (v[j].x * v[j].x + v[j].y * v[j].y) + (v[j].z * v[j].z + v[j].w * v[j].w); }
        const float rstd = 1.0f / sqrtf(wave_sum(s) * (1.0f / DM) + EPS);
        f32x4* o = (f32x4*)(F.out + (size_t)tok * DM) + lane;
#pragma unroll
        for (int j = 0; j < 4; ++j) { const f32x4 g = ((const f32x4*)gf)[lane + 64 * j]; o[64 * j] = v[j] * rstd * g; }
    }
}
__device__ __forceinline__ void pass_pool(Frame& F) {
    const int tid = opaque_tid(), lane = tid & 63; (void)tid;
    const bf16_t* H = (const bf16_t*)(F.ws + WS_H); bf16_t* PL = (bf16_t*)(F.ws + S_PL);
    for (int tok = F.gw; tok < NTOK; tok += F.ngw) {
        int base, T, t;
        if (tok < NP) { base = tok & ~(PSEQ - 1); T = PSEQ; t = tok - base; } else { const int r = tok - NP; base = NP + (r & ~(SSEQ - 1)); T = SSEQ; t = tok - base; }
#pragma unroll
        for (int j = 0; j < 4; ++j) {
            const int w = 2 << j; int lo = t - w / 2; if (lo < 0) lo = 0; int hi = t - w / 2 + w; if (hi > T) hi = T;
            float s0 = 0.f, s1 = 0.f, s2 = 0.f, s3 = 0.f;
            for (int tt = lo; tt < hi; ++tt) { const u32x2 q = *((const u32x2*)(H + (size_t)(base + tt) * DM + 256 * j) + lane);
                s0 += __builtin_bit_cast(float, q.x << 16); s1 += __builtin_bit_cast(float, q.x & 0xffff0000u); s2 += __builtin_bit_cast(float, q.y << 16); s3 += __builtin_bit_cast(float, q.y & 0xffff0000u); }
            const u32x2 q = *((const u32x2*)(H + (size_t)tok * DM + 256 * j) + lane);
            const float inv = 1.0f / (float)(hi - lo);
            const float o0 = s0 * inv - __builtin_bit_cast(float, q.x << 16), o1 = s1 * inv - __builtin_bit_cast(float, q.x & 0xffff0000u);
            const float o2 = s2 * inv - __builtin_bit_cast(float, q.y << 16), o3 = s3 * inv - __builtin_bit_cast(float, q.y & 0xffff0000u);
            u32x2 w2; w2.x = pk2(o0, o1); w2.y = pk2(o2, o3);
            *((u32x2*)(PL + (size_t)tok * DM + 256 * j) + lane) = w2;
        }
    }
}
__device__ __forceinline__ void pass_mla_norm(Frame& F, const Args& A) {
    const int tid = opaque_tid(), lane = tid & 63; (void)tid;
    const float* RAW = (const float*)(F.ws + S_RAW); bf16_t* CQ = (bf16_t*)(F.ws + S_CQ); bf16_t* CALL = (bf16_t*)(F.ws + S_CALL); bf16_t* KF = (bf16_t*)(F.ws + S_KF);
    const float* gq = A.in[12]; const float* gkv = A.in[15];
    float* st_ckv = F.out + (size_t)NTOK * DM; float* st_kpe = st_ckv + (size_t)NP * KVRANK;
    for (int tok = F.gw; tok < NTOK; tok += F.ngw) {
        const float* rr = RAW + (size_t)tok * NDOWN;
        int krow; if (tok < NP) krow = tok; else { const int r = tok - NP; krow = NP + (r / SSEQ) * SKV + PAST + (r % SSEQ); }
        { f32x4 v[3]; float s = 0.f;
#pragma unroll
          for (int j = 0; j < 3; ++j) { v[j] = ((const f32x4*)rr)[lane + 64 * j]; s += (v[j].x * v[j].x + v[j].y * v[j].y) + (v[j].z * v[j].z + v[j].w * v[j].w); }
          const float rstd = 1.0f / sqrtf(wave_sum(s) * (1.0f / QRANK) + EPS);
#pragma unroll
          for (int j = 0; j < 3; ++j) { const f32x4 g = ((const f32x4*)gq)[lane + 64 * j]; const f32x4 h = v[j] * rstd * g; u32x2 w; w.x = pk2(h.x, h.y); w.y = pk2(h.z, h.w);
              *((u32x2*)(CQ + (size_t)tok * QRANK) + lane + 64 * j) = w; } }
        { f32x4 v[2]; float s = 0.f;
#pragma unroll
          for (int j = 0; j < 2; ++j) { v[j] = ((const f32x4*)(rr + QRANK))[lane + 64 * j]; s += (v[j].x * v[j].x + v[j].y * v[j].y) + (v[j].z * v[j].z + v[j].w * v[j].w); }
          const float rstd = 1.0f / sqrtf(wave_sum(s) * (1.0f / KVRANK) + EPS);
#pragma unroll
          for (int j = 0; j < 2; ++j) { const f32x4 g = ((const f32x4*)gkv)[lane + 64 * j]; const f32x4 h = v[j] * rstd * g; u32x2 w; w.x = pk2(h.x, h.y); w.y = pk2(h.z, h.w);
              *((u32x2*)(CALL + (size_t)krow * KVRANK) + lane + 64 * j) = w;
              if (tok < NP) ((f32x4*)(st_ckv + (size_t)tok * KVRANK))[lane + 64 * j] = h; } }
        { float x = rr[QRANK + KVRANK + lane];
          if (tok < NP) { st_kpe[(size_t)tok * ROPE + lane] = x; }
          else { const int t = (tok - NP) % SSEQ; const int pos = (lane < 32) ? (t >> 6) : (t & 63);
              const float inv = __builtin_amdgcn_exp2f(-(float)(lane & 15) * 0.8304820237218407f);
              const float rev = (float)pos * inv * 0.15915494309189535f;
              const float cs = __builtin_amdgcn_cosf(rev), sn = __builtin_amdgcn_sinf(rev);
              const float partner = __shfl_xor(x, 16);
              x = (lane & 16) ? (x * cs + partner * sn) : (x * cs - partner * sn); }
          const bf16_t xb = (bf16_t)f2bf(x);
#pragma unroll
          for (int h = 0; h < NHEAD; ++h) KF[(size_t)krow * 1536 + h * QKD + 128 + lane] = xb; }
    }
}

__device__ __forceinline__ void xpose_item(const float* W, int N, bf16_t* WT, int ldk, const float* rscale, LAS float* scr, int item, int lane) {
    const int nblk = N / 32, kb = item / nblk, nb = item % nblk, k0 = 64 * kb, n0 = 32 * nb;
#pragma unroll 8
    for (int i = 0; i < 32; ++i) { const int kk = 2 * i + (lane >> 5); scr[kk * 33 + (lane & 31)] = W[(size_t)(k0 + kk) * N + n0 + (lane & 31)]; }
    asm volatile("s_waitcnt lgkmcnt(0)" ::: "memory");
    const int c = lane & 7;
#pragma unroll
    for (int j = 0; j < 4; ++j) { const int n = (lane >> 3) + 8 * j; const LAS float* s = scr + (8 * c) * 33 + n; const float sc = rscale ? rscale[n0 + n] : 1.0f;
        u32x4 o; o.x = pk2(s[0 * 33] * sc, s[1 * 33] * sc); o.y = pk2(s[2 * 33] * sc, s[3 * 33] * sc); o.z = pk2(s[4 * 33] * sc, s[5 * 33] * sc); o.w = pk2(s[6 * 33] * sc, s[7 * 33] * sc);
        *(u32x4*)(WT + (size_t)(n0 + n) * ldk + k0 + 8 * c) = o; }
    asm volatile("s_waitcnt lgkmcnt(0)" ::: "memory");
}
struct XJob { const float* W; int K, N; bf16_t* WT; int ldk; const float* rscale; int items; };
__device__ __forceinline__ XJob xjob(Frame& F, const Args& A, int j) {
    XJob x; x.rscale = nullptr; unsigned char* ws = F.ws;
    if (j < 2)       { x.W = A.in[8] + (size_t)j * 1024 * 1024; x.K = 1024; x.N = 1024; x.WT = (bf16_t*)(ws + WS_WFT) + (size_t)j * 1024 * 1024; }
    else if (j < 6)  { const int g = j - 2; x.W = A.in[9] + (size_t)g * 256 * 256; x.K = 256; x.N = 256; x.WT = (bf16_t*)(ws + WS_WPT) + (size_t)g * 256 * 256; x.rscale = A.in[10] + g * 256; }
    else if (j == 6) { x.W = A.in[11]; x.K = 1024; x.N = 768; x.WT = (bf16_t*)(ws + WS_WDT); }
    else if (j == 7) { x.W = A.in[14]; x.K = 1024; x.N = 576; x.WT = (bf16_t*)(ws + WS_WDT) + (size_t)768 * 1024; }
    else if (j == 8) { x.W = A.in[13]; x.K = 768; x.N = 1536; x.WT = (bf16_t*)(ws + WS_WUQT); }
    else if (j == 9) { x.W = A.in[16]; x.K = 512; x.N = 2048; x.WT = (bf16_t*)(ws + WS_WUKVT); }
    else if (j == 10) { x.W = A.in[17]; x.K = 1024; x.N = 1024; x.WT = (bf16_t*)(ws + WS_WOT); }
    else if (j < 15) { const int l = j - 11; x.W = A.in[18] + (size_t)l * 1024 * DFF2; x.K = 1024; x.N = DFF2; x.WT = (bf16_t*)(ws + WS_WIN) + (size_t)l * DFF2 * 1024; }
    else             { const int l = j - 15; x.W = A.in[21] + (size_t)l * DFF * 1024; x.K = DFF; x.N = 1024; x.WT = (bf16_t*)(ws + WS_WOUT) + (size_t)l * 1024 * DFF; }
    x.ldk = x.K; x.items = (x.K / 64) * (x.N / 32);
    return x;
}
__device__ __forceinline__ void p0_prologue(Frame& F, const Args& A) {
    const int tid = opaque_tid(), lane = tid & 63; (void)tid;
    unsigned char* ws = F.ws;
    { const f32x4* s0 = (const f32x4*)A.in[0]; const f32x4* s1 = (const f32x4*)A.in[1]; f32x4* d = (f32x4*)(ws + WS_X);
      const size_t n0 = (size_t)NP * DM / 4, n1 = (size_t)NS * DM / 4, stride = (size_t)F.G * 512;
      for (size_t i = (size_t)F.vcu * 512 + tid; i < n0 + n1; i += stride) d[i] = (i < n0) ? s0[i] : s1[i - n0]; }
    { const int gt = F.vcu * 512 + tid;
      if (gt < 4 * 16 * 1536) {
          const int layer = gt / (16 * 1536), rem = gt % (16 * 1536), kr = rem / 1536, c4 = rem % 1536;
          const float* W = A.in[6] + (size_t)layer * 1024 * 6144 + (size_t)kr * 64 * 6144 + c4 * 4;
          const float* cc = A.in[5]; const float* c0 = A.in[4]; const float* c1 = A.in[4] + 1024;
          f32x4 a0 = {0.f, 0.f, 0.f, 0.f}, a1 = a0, a2 = a0;
#pragma unroll 8
          for (int k = 0; k < 64; ++k) { const f32x4 w = *(const f32x4*)(W + (size_t)k * 6144); const int kk = kr * 64 + k;
              a0 += w * silu_f(cc[kk]); a1 += w * silu_f(c0[kk]); a2 += w * silu_f(c1[kk]); }
          if (kr == 0) { const f32x4 b = *(const f32x4*)(A.in[7] + (size_t)layer * 6144 + c4 * 4); a0 += b; a1 += b; a2 += b; }
          unsigned long long* M = (unsigned long long*)(ws + WS_CTL + CTL_MOD_OFF) + (size_t)layer * 3 * 6144 + c4 * 4;
#pragma unroll
          for (int e = 0; e < 4; ++e) {
              atomicAdd(M + e, (unsigned long long)(long long)rintf(a0[e] * 4294967296.0f)); atomicAdd(M + 6144 + e, (unsigned long long)(long long)rintf(a1[e] * 4294967296.0f));
              atomicAdd(M + 2 * 6144 + e, (unsigned long long)(long long)rintf(a2[e] * 4294967296.0f)); }
      } }
    { LAS float* scr = (LAS float*)(F.lds + F.wave * 16384);
      int base = 0;
      for (int j = 0; j < 19; ++j) { const XJob x = xjob(F, A, j);
          int it = F.gw - (base % F.ngw); if (it < 0) it += F.ngw;
          for (; it < x.items; it += F.ngw) xpose_item(x.W, x.N, x.WT, x.ldk, x.rscale, scr, it, lane);
          base += x.items; } }
    { u32x4* d = (u32x4*)((bf16_t*)(ws + WS_WDT) + (size_t)1344 * 1024); const size_t n = (size_t)192 * 1024 * 2 / 16;
      for (size_t i = (size_t)F.vcu * 512 + tid; i < n; i += (size_t)F.G * 512) d[i] = (u32x4){0u, 0u, 0u, 0u}; }
    { bf16_t* ds = (bf16_t*)(ws + WS_DFTS); const size_t n = (size_t)SSEQ * 2 * SSEQ / 2; const float sc = 0.022097086912079608f;
      for (size_t i = (size_t)F.vcu * 512 + tid; i < n; i += (size_t)F.G * 512) { const int t = (int)(i / SSEQ); const int k2 = (int)(i % SSEQ) * 2; float v[2];
#pragma unroll
          for (int e = 0; e < 2; ++e) { const int kk = k2 + e; const int s = kk & (SSEQ - 1); const float rev = (float)((t * s) & (SSEQ - 1)) * (1.0f / SSEQ);
              v[e] = (kk < SSEQ) ? __builtin_amdgcn_cosf(rev) * sc : -__builtin_amdgcn_sinf(rev) * sc; }
          ((unsigned*)ds)[i] = pk2(v[0], v[1]); }
      bf16_t* dp = (bf16_t*)(ws + WS_DFTP); const size_t np = (size_t)PSEQ * 2 * PSEQ / 2;
      for (size_t i = (size_t)F.vcu * 512 + tid; i < np; i += (size_t)F.G * 512) { const int t = (int)(i / PSEQ); const int k2 = (int)(i % PSEQ) * 2; float v[2];
#pragma unroll
          for (int e = 0; e < 2; ++e) { const int kk = k2 + e; const int s = kk & (PSEQ - 1); const float rev = (float)((t * s) & (PSEQ - 1)) * (1.0f / PSEQ);
              v[e] = (kk < PSEQ) ? __builtin_amdgcn_cosf(rev) * 0.0625f : -__builtin_amdgcn_sinf(rev) * 0.0625f; }
          ((unsigned*)dp)[i] = pk2(v[0], v[1]); }
      bf16_t* dc = (bf16_t*)(ws + WS_C256); const size_t nc = (size_t)512 * 256 / 2;
      for (size_t i = (size_t)F.vcu * 512 + tid; i < nc; i += (size_t)F.G * 512) { const int r = (int)(i / 128); const int j2 = (int)(i % 128) * 2; float v[2];
#pragma unroll
          for (int e = 0; e < 2; ++e) { const int j = j2 + e; const float rev = (float)(((r & 255) * j) & 255) * (1.0f / 256.0f);
              v[e] = (r < 256) ? __builtin_amdgcn_cosf(rev) * 0.0625f : __builtin_amdgcn_sinf(rev) * 0.0625f; }
          ((unsigned*)dc)[i] = pk2(v[0], v[1]); } }
    { const float* cc = A.in[2]; const float* ck = A.in[3]; bf16_t* CALL = (bf16_t*)(ws + S_CALL); bf16_t* KF = (bf16_t*)(ws + S_KF);
      for (int r = F.gw; r < NSB * PAST; r += F.ngw) { const int b = r / PAST, j = r % PAST; const int krow = NP + b * SKV + j;
#pragma unroll
          for (int q = 0; q < 2; ++q) { const f32x4 v = ((const f32x4*)(cc + (size_t)r * KVRANK))[lane + 64 * q]; u32x2 w; w.x = pk2(v.x, v.y); w.y = pk2(v.z, v.w);
              *((u32x2*)(CALL + (size_t)krow * KVRANK) + lane + 64 * q) = w; }
          const bf16_t xb = (bf16_t)f2bf(ck[(size_t)r * ROPE + lane]);
#pragma unroll
          for (int h = 0; h < NHEAD; ++h) KF[(size_t)krow * 1536 + h * QKD + 128 + lane] = xb; } }
}

namespace att {
constexpr int KVBLK = 64, QBLK = 32;
constexpr int SHM_V = KVBLK * VD * 2, SHM_K = KVBLK * QKD * 2;
constexpr int SHM_ATTN = 2 * SHM_V + 2 * SHM_K + 8 * 64 * 4;
constexpr int LDQ = 1536, LDK = 1536, LDV = 1024, LDO = 1024;
constexpr float THR = 8.f;
#define KSWZ(row, colB) ((row) * 384 + ((colB) ^ (((row) & 7) << 4)))
#define SBAR() __builtin_amdgcn_sched_barrier(0)
__device__ __forceinline__ int crow(int r, int hi) { return (r & 3) + 8 * (r >> 2) + 4 * hi; }
__device__ __forceinline__ void partialSM(f32x16& p0, f32x16& p1, float& m_reg, float& mn, float& alpha) {
  constexpr float C = SM_SCALE * 1.4426950408889634f;
  float pmax = p0[0];
#pragma unroll
  for (int r = 1; r < 16; ++r) pmax = fmaxf(pmax, p0[r]);
#pragma unroll
  for (int r = 0; r < 16; ++r) pmax = fmaxf(pmax, p1[r]);
  { auto rr = __builtin_amdgcn_permlane32_swap(__float_as_uint(pmax), __float_as_uint(pmax), false, false);
    pmax = fmaxf(__uint_as_float(rr[0]), __uint_as_float(rr[1])); }
  if (__builtin_expect(__all(pmax - m_reg <= THR / SM_SCALE), 1)) { mn = m_reg; alpha = 1.f; }
  else { mn = fmaxf(m_reg, pmax); alpha = __builtin_amdgcn_exp2f((m_reg - mn) * C); m_reg = mn; }
  float mnC = -mn * C;
#pragma unroll
  for (int r = 0; r < 16; ++r) p0[r] = fmaf(p0[r], C, mnC);
#pragma unroll
  for (int r = 0; r < 16; ++r) p1[r] = fmaf(p1[r], C, mnC);
#pragma unroll
  for (int r = 0; r < 16; ++r) p0[r] = __builtin_amdgcn_exp2f(p0[r]);
}
__device__ __forceinline__ void finishSM(f32x16& p0, f32x16& p1, float alpha, float& l_reg, bf16x8& pa0, bf16x8& pa1, bf16x8& pa2, bf16x8& pa3) {
#pragma unroll
  for (int r = 0; r < 16; ++r) p1[r] = __builtin_amdgcn_exp2f(p1[r]);
  float ps = 0;
#pragma unroll
  for (int r = 0; r < 16; ++r) ps += p0[r];
#pragma unroll
  for (int r = 0; r < 16; ++r) ps += p1[r];
  { auto rr = __builtin_amdgcn_permlane32_swap(__float_as_uint(ps), __float_as_uint(ps), false, false);
    ps = __uint_as_float(rr[0]) + __uint_as_float(rr[1]); }
  l_reg = l_reg * alpha + ps;
#define PK4(P, BASE, OUT) do { unsigned a0 = cvt_pk_bf16(P[BASE + 0], P[BASE + 1]), a1 = cvt_pk_bf16(P[BASE + 2], P[BASE + 3]);   \
    unsigned b0 = cvt_pk_bf16(P[BASE + 4], P[BASE + 5]), b1 = cvt_pk_bf16(P[BASE + 6], P[BASE + 7]);                              \
    auto r0 = __builtin_amdgcn_permlane32_swap(a0, b0, false, false); auto r1 = __builtin_amdgcn_permlane32_swap(a1, b1, false, false); \
    u32x4 w = {r0[0], r1[0], r0[1], r1[1]}; OUT = *reinterpret_cast<bf16x8*>(&w); } while (0)
  PK4(p0, 0, pa0); PK4(p0, 8, pa1); PK4(p1, 0, pa2); PK4(p1, 8, pa3);
#undef PK4
}
__device__ __forceinline__ void qkt(f32x16& p0, f32x16& p1, const char* Ks, const bf16x8* qr, int r32, int hi) {
  p0 = f32x16{}; p1 = f32x16{};
#pragma unroll
  for (int d0 = 0; d0 < 12; ++d0) { int cb = (d0 * 16 + hi * 8) * 2;
    bf16x8 b0 = *reinterpret_cast<const bf16x8*>(Ks + KSWZ(r32, cb));
    bf16x8 b1 = *reinterpret_cast<const bf16x8*>(Ks + KSWZ(32 + r32, cb));
    p0 = __builtin_amdgcn_mfma_f32_32x32x16_bf16(b0, qr[d0], p0, 0, 0, 0);
    p1 = __builtin_amdgcn_mfma_f32_32x32x16_bf16(b1, qr[d0], p1, 0, 0, 0); }
}
__device__ __forceinline__ int v_st(int k, int c) { const int kk = (k & ~0xC) | ((k & 4) << 1) | ((k & 8) >> 1); return ((kk >> 3) * 4 + (c >> 5)) * 512 + ((kk & 7) * 32 + (c & 31)) * 2; }
__device__ __forceinline__ int v_rd_base(int lane) { return ((lane & 3) << 3) | (((lane >> 2) & 3) << 6) | (((lane >> 4) & 1) << 5) | (((lane >> 5) & 1) << 8); }
constexpr int v_rd_off(int d0, int ks, int half) { return d0 * 512 + ks * 4096 + half * 2048; }
template <int OFF> __device__ __forceinline__ s16x4 tr_read(int vb) {
  s16x4 r; asm volatile("ds_read_b64_tr_b16 %0, %1 offset:%2" : "=&v"(r) : "v"(vb), "i"(OFF) : "memory"); return r;
}
template <int D0> __device__ __forceinline__ void pv_one(f32x16& od, int vb, bf16x8 pa0, bf16x8 pa1, bf16x8 pa2, bf16x8 pa3) {
  const s16x4 l0 = tr_read<v_rd_off(D0, 0, 0)>(vb), h0 = tr_read<v_rd_off(D0, 0, 1)>(vb), l1 = tr_read<v_rd_off(D0, 1, 0)>(vb), h1 = tr_read<v_rd_off(D0, 1, 1)>(vb);
  const s16x4 l2 = tr_read<v_rd_off(D0, 2, 0)>(vb), h2 = tr_read<v_rd_off(D0, 2, 1)>(vb), l3 = tr_read<v_rd_off(D0, 3, 0)>(vb), h3 = tr_read<v_rd_off(D0, 3, 1)>(vb);
  asm volatile("s_waitcnt lgkmcnt(0)" ::: "memory"); SBAR();
#define PK(L, H) (bf16x8){L[0], L[1], L[2], L[3], H[0], H[1], H[2], H[3]}
  od = __builtin_amdgcn_mfma_f32_32x32x16_bf16(pa0, PK(l0, h0), od, 0, 0, 0);
  od = __builtin_amdgcn_mfma_f32_32x32x16_bf16(pa1, PK(l1, h1), od, 0, 0, 0);
  od = __builtin_amdgcn_mfma_f32_32x32x16_bf16(pa2, PK(l2, h2), od, 0, 0, 0);
  od = __builtin_amdgcn_mfma_f32_32x32x16_bf16(pa3, PK(l3, h3), od, 0, 0, 0);
#undef PK
}
__device__ __forceinline__ void pv_d0(f32x16* o, int vb, bf16x8 pa0, bf16x8 pa1, bf16x8 pa2, bf16x8 pa3) {
  pv_one<0>(o[0], vb, pa0, pa1, pa2, pa3); pv_one<1>(o[1], vb, pa0, pa1, pa2, pa3); pv_one<2>(o[2], vb, pa0, pa1, pa2, pa3); pv_one<3>(o[3], vb, pa0, pa1, pa2, pa3);
}
__device__ __forceinline__ void rope_pair(bf16x8& x1, bf16x8& x2, int pos, int hi) {
#pragma unroll
  for (int e = 0; e < 8; ++e) {
    const float inv = __builtin_amdgcn_exp2f(-(float)(hi * 8 + e) * 0.8304820237218407f);
    const float rev = (float)pos * inv * 0.15915494309189535f;
    const float cs = __builtin_amdgcn_cosf(rev), sn = __builtin_amdgcn_sinf(rev);
    const float a = bf2f((unsigned short)x1[e]), b = bf2f((unsigned short)x2[e]);
    x1[e] = (short)f2bf(a * cs - b * sn); x2[e] = (short)f2bf(b * cs + a * sn);
  }
}
__device__ __forceinline__ void attn_unit(const bf16_t* __restrict__ Qb, const bf16_t* __restrict__ Kh, const bf16_t* __restrict__ Vh, bf16_t* __restrict__ Ob, int seq, int rope_t0, char* lds) {
  int tid_ = threadIdx.x; asm volatile("" : "+v"(tid_));
  const int tid = tid_, wid = tid >> 6, lane = tid & 63, r32 = lane & 31, hi = lane >> 5;
  char* V_lds = lds; char* K_lds = lds + 2 * SHM_V;
  float* wsf = (float*)(lds + 2 * SHM_V + 2 * SHM_K) + wid * 64; float* li_l = wsf; float* al_l = wsf + 32;
  float m_reg = -1e30f, l_reg = 0; f32x16 o[4] = {}; bf16x8 qr[12];
  const bf16_t* Qw = Qb + (long)(wid * QBLK + r32) * LDQ + hi * 8;
#pragma unroll
  for (int d0 = 0; d0 < 12; ++d0) qr[d0] = *reinterpret_cast<const bf16x8*>(Qw + d0 * 16);
  if (rope_t0 >= 0) { const int t = rope_t0 + wid * QBLK + r32; rope_pair(qr[8], qr[9], t >> 6, hi); rope_pair(qr[10], qr[11], t & 63, hi); }
  const int sr = tid >> 4, sc = (tid & 15) * 8, vst0 = v_st(sr, sc), vst1 = v_st(32 + sr, sc);
  const int kr0 = tid / 24, kc0 = tid % 24, kr1 = (tid + 512) / 24, kc1 = (tid + 512) % 24, kr2 = (tid + 1024) / 24, kc2 = (tid + 1024) % 24;
  const int vb0 = (int)(uintptr_t)V_lds + v_rd_base(lane);
  bf16x8 s_v0, s_v1, s_k0, s_k1, s_k2;
#define SLOAD(k0) do { s_v0 = *reinterpret_cast<const bf16x8*>(&Vh[(long)((k0) + sr) * LDV + sc]); s_v1 = *reinterpret_cast<const bf16x8*>(&Vh[(long)((k0) + 32 + sr) * LDV + sc]); \
    s_k0 = *reinterpret_cast<const bf16x8*>(&Kh[(long)((k0) + kr0) * LDK + kc0 * 8]); s_k1 = *reinterpret_cast<const bf16x8*>(&Kh[(long)((k0) + kr1) * LDK + kc1 * 8]); \
    s_k2 = *reinterpret_cast<const bf16x8*>(&Kh[(long)((k0) + kr2) * LDK + kc2 * 8]); } while (0)
#define SWRITE(b) do { *(bf16x8*)(V_lds + (b) * SHM_V + vst0) = s_v0; *(bf16x8*)(V_lds + (b) * SHM_V + vst1) = s_v1; \
    *(bf16x8*)(K_lds + (b) * SHM_K + KSWZ(kr0, kc0 * 16)) = s_k0; *(bf16x8*)(K_lds + (b) * SHM_K + KSWZ(kr1, kc1 * 16)) = s_k1; *(bf16x8*)(K_lds + (b) * SHM_K + KSWZ(kr2, kc2 * 16)) = s_k2; } while (0)
#define RESC(a) do { if (__any((a) < 1.f)) { if (hi == 0) al_l[r32] = (a); asm volatile("s_waitcnt lgkmcnt(0)" ::: "memory"); \
    _Pragma("unroll") for (int d = 0; d < 4; ++d) _Pragma("unroll") for (int r = 0; r < 16; ++r) o[d][r] *= al_l[crow(r, hi)]; } } while (0)
  f32x16 p0, p1; float mn, al; bf16x8 pa0, pa1, pa2, pa3; const int NT = seq / KVBLK;
  SLOAD(0); SWRITE(0); __syncthreads();
  for (int j = 0; j < NT; ++j) {
    const int buf = j & 1;
    if (j + 1 < NT) SLOAD((j + 1) * KVBLK);
    SBAR(); qkt(p0, p1, K_lds + buf * SHM_K, qr, r32, hi);
    partialSM(p0, p1, m_reg, mn, al);
    RESC(al);
    finishSM(p0, p1, al, l_reg, pa0, pa1, pa2, pa3); SBAR();
    pv_d0(o, vb0 + buf * SHM_V, pa0, pa1, pa2, pa3);
    if (j + 1 < NT) SWRITE(buf ^ 1);
    __syncthreads();
  }
  if (hi == 0) li_l[r32] = l_reg; asm volatile("s_waitcnt lgkmcnt(0)" ::: "memory");
  float rli[16];
#pragma unroll
  for (int r = 0; r < 16; ++r) rli[r] = __builtin_amdgcn_rcpf(li_l[crow(r, hi)]);
  bf16_t* Ow = Ob + (long)(wid * QBLK) * LDO;
#pragma unroll
  for (int r = 0; r < 16; ++r) { const int orow = crow(r, hi);
#pragma unroll
    for (int d0 = 0; d0 < 4; ++d0) Ow[(long)orow * LDO + d0 * 32 + r32] = (bf16_t)f2bf(o[d0][r] * rli[r]); }
  __syncthreads();
#undef SLOAD
#undef SWRITE
#undef RESC
}
}

constexpr int N_PHASES = 29;
#ifndef DBG_MASK
#define DBG_MASK 0xFFFF
#endif
#define EN(b) ((DBG_MASK >> (b)) & 1)
__device__ __forceinline__ GemmDesc mk_gemm(int kind, int epi, int perm, int total, int lda, int ldb, int hsA, int hsB, int ldc0, int ldc1, int layer, int li) {
    GemmDesc g; g.kind = kind; g.epi = epi; g.perm = perm; g.total = total; g.lda = lda; g.ldb = ldb; g.hsA = hsA; g.hsB = hsB; g.ldc0 = ldc0; g.ldc1 = ldc1; g.layer = layer; g.li = li;
    return g;
}
#define RUN_GEMM(g, GG, cc) gemm_phase(F.lds, g, F.ws, args.in[19], args.in[20], GG, cc)
__device__ __forceinline__ void run_attention(Frame& F) {
    const bf16_t* QF = (const bf16_t*)(F.ws + S_QF); const bf16_t* KF = (const bf16_t*)(F.ws + S_KF); const bf16_t* VF = (const bf16_t*)(F.ws + S_VF); bf16_t* O = (bf16_t*)(F.ws + S_O);
    char* lds = (char*)F.lds;
    const int c = (int)blockIdx.x;
    const bool g256 = (F.G == 256);
    const int nu = g256 ? (c < 128 ? 1 : 2) : (384 - c + F.G - 1) / F.G;
    for (int k = 0; k < nu; ++k) {
        const int uidx = g256 ? (c < 128 ? c : 128 + 2 * (c - 128) + k) : c + k * F.G;
        const bool lat = uidx < 128;
        int tok0, krow0, h, seq, rt0;
        if (lat) { const int b = uidx >> 6, qb = uidx & 7; h = (uidx >> 3) & 7; tok0 = NP + b * SSEQ + qb * 256; krow0 = NP + b * SKV; seq = SKV; rt0 = qb * 256; }
        else { const int v = uidx - 128, b = v >> 3; h = v & 7; tok0 = b * PSEQ; krow0 = tok0; seq = PSEQ; rt0 = -1; }
        att::attn_unit(QF + (size_t)tok0 * 1536 + h * QKD, KF + (size_t)krow0 * 1536 + h * QKD, VF + (size_t)krow0 * 1024 + h * VD, O + (size_t)tok0 * 1024 + h * VD, seq, rt0, lds);
    }
}

__global__ void __launch_bounds__(512, 2) mega_fwd(Args args) {
    extern __shared__ __attribute__((aligned(16))) unsigned char lds_raw[];
    Frame F;
    F.lds = (LAS unsigned char*)lds_raw; F.ws = args.ws; F.out = args.out;
    F.wave = __builtin_amdgcn_readfirstlane(threadIdx.x >> 6);
    F.G = gridDim.x; { const int bx = blockIdx.x; F.vcu = (F.G % 8 == 0) ? (bx % 8) * (F.G / 8) + bx / 8 : bx; }
    F.gw = F.vcu * 8 + F.wave; F.ngw = F.G * 8;
    volatile LAS unsigned* MISC = (volatile LAS unsigned*)(F.lds + MISC_OFF);
    for (int u = threadIdx.x; u < (LDS_BYTES - LDSCTL_OFF) / 4; u += 512) ((LAS unsigned*)(F.lds + LDSCTL_OFF))[u] = 0u;
    __syncthreads();
    unsigned* barw = (unsigned*)(F.ws + WS_CTL) + CW_BAR;
    XcdBarrier bar; bar.bar = barw; bar.x = 0; bar.st = nullptr;
    const int lo = args.ph_lo, hi = args.ph_hi;
    const bool multi = (hi - lo) > 1;
    if (multi) bar = xcd_barrier_post(barw, MISC + 8);
#define IN(k) (lo <= (k) && (k) < hi)
#define SEAM(k) do { if (IN(k) && IN((k) + 1)) xcd_barrier(bar); } while (0)
    int ph = 0;
    const int cx = (int)blockIdx.x;
    if (EN(0) && IN(ph)) { p0_prologue(F, args); } SEAM(ph); ++ph;
    if (EN(1) && IN(ph)) { { const GemmDesc g = mk_gemm(GK_WCOMB, EK_BF16, 1, 64, 1024, 256, 128 * 1024 * 2, 128 * 256 * 2, 1024, 1024, 0, 0); RUN_GEMM(g, F.G, cx); }
                  pass_modulate(F, 0, 0); } SEAM(ph); ++ph;
    for (int layer = 0; layer < 4; ++layer) {
        const int kind = layer % 3;
        if (layer > 0) { if (EN(2) && IN(ph)) pass_modulate(F, layer, 0); SEAM(ph); ++ph; }
        if (kind == 0) {
            if (EN(3) && IN(ph)) { const GemmDesc g = mk_gemm(GK_F1, EK_BF16, 1, 8 * 48, DM, DM, 128 * DM * 2, 128 * DM * 2, 0, 0, layer, layer / 3); RUN_GEMM(g, F.G, cx); } SEAM(ph); ++ph;
            if (EN(4) && IN(ph)) {
                if (F.G >= 128) {
                    if (cx >= 64) { const GemmDesc g = mk_gemm(GK_F2P, EK_XRES, 0, 128, 512, 512, 128 * 512 * 2, 128 * 512 * 2, 0, 0, layer, 0); RUN_GEMM(g, F.G - 64, cx - 64); }
                    else { const GemmDesc g = mk_gemm(GK_F2S, EK_XRES, 0, 64, 4096, 4096, 128 * 4096 * 2, 128 * 4096 * 2, 0, 0, layer, 0); RUN_GEMM(g, 64, cx); }
                } else {
                    { const GemmDesc g = mk_gemm(GK_F2S, EK_XRES, 0, 64, 4096, 4096, 128 * 4096 * 2, 128 * 4096 * 2, 0, 0, layer, 0); RUN_GEMM(g, F.G, cx); }
                    { const GemmDesc g = mk_gemm(GK_F2P, EK_XRES, 0, 128, 512, 512, 128 * 512 * 2, 128 * 512 * 2, 0, 0, layer, 0); RUN_GEMM(g, F.G, cx); }
                } } SEAM(ph); ++ph;
        } else if (kind == 1) {
            if (EN(5) && IN(ph)) pass_pool(F); SEAM(ph); ++ph;
            if (EN(6) && IN(ph)) { const GemmDesc g = mk_gemm(GK_POOL, EK_XRES, 0, 48 * 4, DM, 256, 128 * DM * 2, 128 * 256 * 2, 0, 0, layer, 0); RUN_GEMM(g, F.G, cx); } SEAM(ph); ++ph;
        } else {
            if (EN(7) && IN(ph)) { const GemmDesc g = mk_gemm(GK_A1, EK_F32, 0, 48 * 6, DM, DM, 128 * DM * 2, 128 * DM * 2, NDOWN, NDOWN, layer, 0); RUN_GEMM(g, F.G, cx); } SEAM(ph); ++ph;
            if (EN(8) && IN(ph)) pass_mla_norm(F, args); SEAM(ph); ++ph;
            if (EN(9) && IN(ph)) { { const GemmDesc g = mk_gemm(GK_A3KV, EK_BF16, 1, 50 * 8, KVRANK, KVRANK, 128 * KVRANK * 2, 128 * KVRANK * 2, 1536, 1024, layer, 0); RUN_GEMM(g, F.G, cx); }
                          { const GemmDesc g = mk_gemm(GK_A3Q, EK_BF16, 1, 48 * 6, QRANK, QRANK, 128 * QRANK * 2, 128 * QRANK * 2, 1536, 1536, layer, 0); RUN_GEMM(g, F.G, cx); } } SEAM(ph); ++ph;
            if (EN(10) && IN(ph)) run_attention(F); SEAM(ph); ++ph;
            if (EN(11) && IN(ph)) { const GemmDesc g = mk_gemm(GK_A5, EK_XRES, 0, 48 * 4, DM, DM, 128 * DM * 2, 128 * DM * 2, 0, 0, layer, 0); RUN_GEMM(g, F.G, cx); } SEAM(ph); ++ph;
        }
        if (EN(2) && IN(ph)) pass_modulate(F, layer, 3); SEAM(ph); ++ph;
        if (EN(12) && IN(ph)) { const GemmDesc g = mk_gemm(GK_FFN1, EK_FFN1, 1, 50 * 22, DM, DM, 128 * DM * 2, DFF * DM * 2, 0, 0, layer, 0); RUN_GEMM(g, F.G, cx); } SEAM(ph); ++ph;
        if (EN(13) && IN(ph)) { const GemmDesc g = mk_gemm(GK_FFN2, EK_XRES, 0, 48 * 4, DFF, DFF, 128 * DFF * 2, 128 * DFF * 2, 0, 0, layer, 0); RUN_GEMM(g, F.G, cx); } SEAM(ph); ++ph;
    }
    if (EN(14) && IN(ph)) pass_final(F, args);
#undef IN
#undef SEAM
}

extern "C" void kernel_launch(void* const* d_in, const int* in_sizes, int n_in, void* d_out, int out_size, void* d_ws, size_t ws_size, hipStream_t stream) {
    static int grid = 0;
    if (grid == 0) {
        const long want_out = (long)NTOK * DM + (long)NP * KVRANK + (long)NP * ROPE;
        if (n_in != 23 || in_sizes[0] != NP * DM || in_sizes[1] != NS * DM || (long)out_size != want_out || ws_size < WS_END) {
            fprintf(stderr, "kernel_launch: unexpected shapes: n_in %d in0 %d in1 %d out %d (want %ld) ws %zu (need %zu); nothing launched\n", n_in, n_in > 0 ? in_sizes[0] : -1, n_in > 1 ? in_sizes[1] : -1, out_size, want_out, ws_size, (size_t)WS_END);
            grid = -1; return; }
        int dev = 0, cus = 0;
        if (hipGetDevice(&dev) != hipSuccess || hipDeviceGetAttribute(&cus, hipDeviceAttributeMultiprocessorCount, dev) != hipSuccess) { fprintf(stderr, "kernel_launch: device query failed\n"); grid = -1; return; }
        if (hipFuncSetAttribute((const void*)mega_fwd, hipFuncAttributeMaxDynamicSharedMemorySize, LDS_BYTES) != hipSuccess) { fprintf(stderr, "kernel_launch: hipFuncSetAttribute failed\n"); grid = -1; return; }
        (void)hipGetLastError();
        grid = cus;
    }
    if (grid < 0) return;
    if (hipMemsetAsync((char*)d_ws + WS_CTL, 0, CTL_ZERO_BYTES, stream) != hipSuccess) { fprintf(stderr, "kernel_launch: memset failed\n"); return; }
    Args a{};
    for (int i = 0; i < 23; ++i) a.in[i] = (const float*)d_in[i];
    a.out = (float*)d_out; a.ws = (unsigned char*)d_ws;
#if MK_PER_PHASE
    for (int p = 0; p < N_PHASES; ++p) { a.ph_lo = p; a.ph_hi = p + 1; hipLaunchKernelGGL(mega_fwd, dim3(grid), dim3(512), LDS_BYTES, stream, a); }
#else
    a.ph_lo = 0; a.ph_hi = N_PHASES; hipLaunchKernelGGL(mega_fwd, dim3(grid), dim3(512), LDS_BYTES, stream, a);
#endif
    const hipError_t le = hipPeekAtLastError();
    if (le != hipSuccess) fprintf(stderr, "kernel_launch: launch failed: %s\n", hipGetErrorName(le));
}
```

```cpp
#include <hip/hip_runtime.h>
#include <cstdio>
#include <cstdint>

#ifndef MK_PER_PHASE
#define MK_PER_PHASE 0
#endif

#define LAS __attribute__((address_space(3)))
#define GAS __attribute__((address_space(1)))
typedef unsigned short bf16_t;
typedef short bf16x8 __attribute__((ext_vector_type(8)));
typedef short s16x4 __attribute__((ext_vector_type(4)));
typedef float f32x4 __attribute__((ext_vector_type(4)));
typedef float f32x2 __attribute__((ext_vector_type(2)));
typedef float f32x16 __attribute__((ext_vector_type(16)));
typedef unsigned u32x4 __attribute__((ext_vector_type(4)));
typedef unsigned u32x2 __attribute__((ext_vector_type(2)));

constexpr int DM = 1024, NPB = 32, PSEQ = 256, NSB = 2, SSEQ = 2048, PAST = 256;
constexpr int NP = NPB * PSEQ;
constexpr int NS = NSB * SSEQ;
constexpr int NTOK = NP + NS;
constexpr int DFF = 2816, DFF2 = 5632;
constexpr int QRANK = 768, KVRANK = 512, ROPE = 64, NHEAD = 8, QKD = 192, VD = 128;
constexpr int NDOWN = 1536;
constexpr int KVROWS = NP + NSB * (PAST + SSEQ);
constexpr int SKV = PAST + SSEQ;
constexpr float EPS = 1e-6f;
constexpr float SM_SCALE = 0.07216878364870322f;

constexpr size_t MiB = 1u << 20;
constexpr size_t WS_CTL = 0, CTL_ZERO_BYTES = 1 * MiB;
constexpr size_t WS_X = 1 * MiB;
constexpr size_t WS_H = 49 * MiB;
constexpr size_t WS_WIN = 74 * MiB;
constexpr size_t WS_WOUT = 118 * MiB;
constexpr size_t WS_WFT = 140 * MiB;
constexpr size_t WS_WCS = 144 * MiB;
constexpr size_t WS_DFTS = 152 * MiB;
constexpr size_t WS_DFTP = 168 * MiB;
constexpr size_t WS_WPT = 169 * MiB;
constexpr size_t WS_WDT = 170 * MiB;
constexpr size_t WS_WUQT = 173 * MiB;
constexpr size_t WS_WUKVT = 176 * MiB;
constexpr size_t WS_WOT = 178 * MiB;
constexpr size_t WS_C256 = 180 * MiB;
constexpr size_t WS_S = 182 * MiB;
constexpr size_t WS_END = 372 * MiB;
constexpr size_t S_G = WS_S;
constexpr size_t S_ZF = WS_S;
constexpr size_t S_PL = WS_S;
constexpr size_t S_RAW = WS_S;
constexpr size_t S_QF = WS_S;
constexpr size_t S_KF = WS_S + 72 * MiB;
constexpr size_t S_CQ = WS_S + 110 * MiB;
constexpr size_t S_CALL = WS_S + 128 * MiB;
constexpr size_t S_VF = WS_S + 141 * MiB;
constexpr size_t S_O = WS_S + 166 * MiB;
constexpr int CW_BAR = 4096;
constexpr size_t CTL_MOD_OFF = 64 * 1024;

constexpr int RING_BYTES = 131072;
constexpr int XCH_OFF = RING_BYTES;
constexpr int LDSCTL_OFF = RING_BYTES + 8192, MISC_OFF = LDSCTL_OFF + 320;
constexpr int PF_OFF = MISC_OFF + 256;
constexpr int LDS_BYTES = 147456;
#ifndef PF_DIST
#define PF_DIST 0
#endif

__device__ __forceinline__ unsigned f2bf(float f) { unsigned u = __builtin_bit_cast(unsigned, f); return (u + 0x7fffu + ((u >> 16) & 1u)) >> 16; }
__device__ __forceinline__ unsigned pk2(float lo, float hi) { return f2bf(lo) | (f2bf(hi) << 16); }
__device__ __forceinline__ float bf2f(unsigned short b) { return __builtin_bit_cast(float, ((unsigned)b) << 16); }
__device__ __forceinline__ unsigned cvt_pk_bf16(float lo, float hi) { unsigned r; asm volatile("v_cvt_pk_bf16_f32 %0, %1, %2" : "=v"(r) : "v"(lo), "v"(hi)); return r; }
__device__ __forceinline__ int fresh_lane() { unsigned m = ~0u; asm volatile("" : "+s"(m)); return (int)__builtin_amdgcn_mbcnt_hi(m, __builtin_amdgcn_mbcnt_lo(m, 0u)); }
__device__ __forceinline__ float lane_shfl(float v, int src_lane) { return __builtin_bit_cast(float, __builtin_amdgcn_ds_bpermute(src_lane << 2, __builtin_bit_cast(int, v))); }
__device__ __forceinline__ float wave_sum(float v, int lane) {
#pragma unroll
    for (int o = 1; o < 64; o <<= 1) v += lane_shfl(v, lane ^ o);
    return v;
}
__device__ __forceinline__ float silu_f(float x) { return x / (1.0f + __expf(-x)); }

#define XB_TMO      128
#define XB_XCNT(j)  (256  + 64 * (j))
#define XB_XSUB(j)  (1280 + 64 * (j))
#define XB_XGEN(j)  (2304 + 64 * (j))
#define XB_TOP      3328
#define XB_TOPGEN   3392
#define XCD_BAR_WORDS 3456
#define XB_SPIN_CAP (1u << 20)
__device__ __forceinline__ unsigned xb_ld(unsigned* p)              { return __hip_atomic_load(p, __ATOMIC_RELAXED, __HIP_MEMORY_SCOPE_AGENT); }
__device__ __forceinline__ unsigned xb_add(unsigned* p, unsigned v) { return __hip_atomic_fetch_add(p, v, __ATOMIC_RELAXED, __HIP_MEMORY_SCOPE_AGENT); }
__device__ __forceinline__ unsigned xb_xcc_id() { return (unsigned)__builtin_amdgcn_s_getreg((3 << 11) | 20) & 0xFu; }
#define XB_SPIN(cond, bar) do { unsigned _sp = 0; while (cond) { __builtin_amdgcn_s_sleep(1); \
    if ((++_sp & 255u) == 0u) { if (xb_ld(&(bar)[XB_TMO])) break; if (_sp > XB_SPIN_CAP) { atomicAdd(&(bar)[XB_TMO], 1u); break; } } } } while (0)
struct XcdBarrier { unsigned* bar; unsigned x; volatile LAS unsigned* st; };
__device__ __forceinline__ XcdBarrier xcd_barrier_post(unsigned* bar, volatile LAS unsigned* st) {
    XcdBarrier b; b.bar = bar; b.x = xb_xcc_id(); b.st = st;
    if (threadIdx.x == 0) (void)xb_add(&bar[XB_XCNT(b.x)], 1u);
    return b;
}
__device__ __forceinline__ void xcd_barrier_complete(unsigned* bar, unsigned x, unsigned& nloc, unsigned& nx) {
    const unsigned G = gridDim.x * gridDim.y * gridDim.z;
    unsigned sum, cnt, mine, sp = 0u;
    for (;;) {
        sum = 0u; cnt = 0u; mine = 0u;
#pragma unroll
        for (unsigned j = 0; j < 16; ++j) { const unsigned c = xb_ld(&bar[XB_XCNT(j)]); sum += c; cnt += (c > 0u) ? 1u : 0u; mine = (j == x) ? c : mine; }
        if (sum == G) break;
        __builtin_amdgcn_s_sleep(1);
        if ((++sp & 255u) == 0u) { if (xb_ld(&bar[XB_TMO])) break; if (sp > XB_SPIN_CAP) { atomicAdd(&bar[XB_TMO], 1u); break; } }
    }
    nloc = mine > 0u ? mine : 1u; nx = cnt > 0u ? cnt : 1u;
}
__device__ __forceinline__ void xcd_barrier(const XcdBarrier& b) {
    asm volatile("s_waitcnt vmcnt(0)" ::: "memory");
    __syncthreads();
    if (threadIdx.x == 0) {
        unsigned* bar = b.bar;
        __builtin_amdgcn_s_waitcnt(0);
        unsigned nloc = b.st[0], nx = b.st[1];
        if (nloc == 0u) { xcd_barrier_complete(bar, b.x, nloc, nx); b.st[0] = nloc; b.st[1] = nx; }
        const unsigned old = xb_add(&bar[XB_XSUB(b.x)], 1u);
        const unsigned gen = old / nloc;
        if (old + 1u == (gen + 1u) * nloc) {
            __builtin_amdgcn_fence(__ATOMIC_RELEASE, "agent");
            asm volatile("s_waitcnt vmcnt(0)" ::: "memory");
            const unsigned og = xb_add(&bar[XB_TOP], 1u);
            const unsigned tg = og / nx;
            if (og + 1u == (tg + 1u) * nx) xb_add(&bar[XB_TOPGEN], 1u);
            else XB_SPIN(xb_ld(&bar[XB_TOPGEN]) == tg, bar);
            __builtin_amdgcn_fence(__ATOMIC_ACQUIRE, "agent");
            xb_add(&bar[XB_XGEN(b.x)], 1u);
            asm volatile("s_waitcnt vmcnt(0)" ::: "memory");
        } else {
            XB_SPIN(xb_ld(&bar[XB_XGEN(b.x)]) == gen, bar);
            __builtin_amdgcn_fence(__ATOMIC_ACQUIRE, "agent");
            asm volatile("s_waitcnt vmcnt(0)" ::: "memory");
        }
    }
    __syncthreads();
}

namespace pg8 {
constexpr int BM = 256, BK = 64, HALF = 128, HTB = HALF * BK * 2, STAGE_BYTES = 8 * HTB, NXCD = 8, WGM = 8;
__host__ __device__ __forceinline__ int lds_byte(int r, int c) { const int st = (r >> 4) * 2 + (c >> 5), rr = r & 15, cc = c & 31, ob = rr * 64 + cc * 2; return st * 1024 + (ob ^ (((ob >> 9) & 1) << 5)); }
__host__ __device__ __forceinline__ void stage_rc(int b, int& R, int& C) { const int st = b / 1024, sb = b % 1024, swz = sb ^ (((sb >> 9) & 1) << 5); R = (st >> 1) * 16 + swz / 64; C = (st & 1) * 32 + (swz % 64) / 2; }
__host__ __device__ __forceinline__ int perm32(int rho) { const int n = rho >> 4, i = rho & 15; return 8 * (i >> 2) + 4 * n + (i & 3); }
}

enum GemmKind { GK_FFN1 = 0, GK_FFN2, GK_F1, GK_F2S, GK_F2P, GK_POOL, GK_A1, GK_A3Q, GK_A3KV, GK_A5, GK_WCOMB };
enum EpiKind { EK_XRES = 0, EK_BF16, EK_F32, EK_FFN1 };

typedef long long modacc_t;
struct EUnit {
    char* o0; char* o1;
    const float* aux;
    const modacc_t* gate; const modacc_t* gate2;
    const float* aux2;
    int i0, i1, i2, i3;
};
struct GemmDesc {
    int kind, epi, perm;
    int total, lda, ldb;
    int hsA, hsB;
    int ldc0, ldc1;
    int layer, li;
    int dry;
    int mr;
};

struct Args { const float* in[23]; float* out; unsigned char* ws; int ph_lo, ph_hi; };

__device__ __forceinline__ void grid_order(int L, int nM, int nN, int& pm, int& pn) {
    const int nwg = nM * nN; int wgid = L;
    { const int q = nwg / pg8::NXCD, r = nwg % pg8::NXCD, xcd = wgid % pg8::NXCD, off = wgid / pg8::NXCD; wgid = (xcd < r ? xcd * (q + 1) : r * (q + 1) + (xcd - r) * q) + off; }
    const int nig = pg8::WGM * nN, gid = wgid / nig, fm = gid * pg8::WGM, gsz = (nM - fm) < pg8::WGM ? (nM - fm) : pg8::WGM;
    pm = fm + ((wgid % nig) % gsz); pn = (wgid % nig) / gsz;
}
__device__ __forceinline__ const modacc_t* mod_vec(const unsigned char* ws, int layer, int tok, int which) {
    const int cond = tok < NP ? 0 : 1 + (tok - NP) / SSEQ;
    return (const modacc_t*)(ws + WS_CTL + CTL_MOD_OFF) + ((size_t)(layer * 3 + cond) * 6144 + which * 1024);
}
typedef long long i64x2 __attribute__((ext_vector_type(2)));
__device__ __forceinline__ f32x4 mod_ld4(const modacc_t* p) {
    const i64x2 a = *(const i64x2*)p, b = *(const i64x2*)(p + 2);
    f32x4 r; r.x = (float)a.x * 2.3283064365386963e-10f; r.y = (float)a.y * 2.3283064365386963e-10f; r.z = (float)b.x * 2.3283064365386963e-10f; r.w = (float)b.y * 2.3283064365386963e-10f;
    return r;
}
__device__ __forceinline__ void ffn1_tile(int pm, int& tok0, int& p0, int& T, int& rlo, int& rhi) {
    if (pm < 32) { tok0 = pm * 256; p0 = 0; T = 256; rlo = 0; rhi = 256; }
    else { const int j9 = pm - 32, b = j9 / 9, j = j9 % 9; p0 = 254 * j - 1; tok0 = NP + b * SSEQ + p0; T = SSEQ; rlo = 1; rhi = (SSEQ - p0) < 255 ? (SSEQ - p0) : 255; }
}

__device__ __forceinline__ void get_ab(const GemmDesc& g, const unsigned char* ws, int L, const char*& A, const char*& B, int& nt) {
    switch (g.kind) {
    case GK_FFN1: { int pm, pn; grid_order(L, 50, 22, pm, pn); int tok0, p0, T, rlo, rhi; ffn1_tile(pm, tok0, p0, T, rlo, rhi);
        A = (const char*)(ws + WS_H) + (long)tok0 * DM * 2;
        B = (const char*)(ws + WS_WIN) + ((size_t)g.layer * DFF2 + 128 * pn) * DM * 2; nt = 16; } break;
    case GK_FFN2: { int pm, pn; grid_order(L, 64, 4, pm, pn);
        A = (const char*)(ws + S_G) + (size_t)pm * 192 * DFF * 2;
        B = (const char*)(ws + WS_WOUT) + ((size_t)g.layer * DM + pn * 256) * DFF * 2; nt = 44; } break;
    case GK_F1: { int pm, pn; grid_order(L, 8, 48, pm, pn);
        A = (const char*)(ws + WS_WCS) + ((size_t)g.li * 2048 + pm * 256) * DM * 2;
        B = (const char*)(ws + WS_H) + (size_t)pn * 256 * DM * 2; nt = 16; } break;
    case GK_F2S: { const int b = L / 32, mt = (L % 32) / 4, pn = L % 4;
        A = (const char*)(ws + WS_DFTS) + (size_t)mt * 256 * 4096 * 2;
        B = (const char*)(ws + S_ZF) + (size_t)NPB * 1024 * 512 * 2 + ((size_t)b * 1024 + pn * 256) * 4096 * 2; nt = 64; } break;
    case GK_F2P: { const int b = L / 4, pn = L % 4;
        A = (const char*)(ws + WS_DFTP);
        B = (const char*)(ws + S_ZF) + ((size_t)b * 1024 + pn * 256) * 512 * 2; nt = 8; } break;
    case GK_POOL: { int pm, pn; grid_order(L, 64, 4, pm, pn);
        A = (const char*)(ws + S_PL) + ((size_t)pm * 192 * DM + pn * 256) * 2;
        B = (const char*)(ws + WS_WPT) + (size_t)pn * 256 * 256 * 2; nt = 4; } break;
    case GK_A1: { int pm, pn; grid_order(L, 64, 6, pm, pn);
        A = (const char*)(ws + WS_H) + (size_t)pm * 192 * DM * 2;
        B = (const char*)(ws + WS_WDT) + (size_t)pn * 256 * DM * 2; nt = 16; } break;
    case GK_A3Q: { int pm, pn; grid_order(L, 64, 6, pm, pn);
        A = (const char*)(ws + S_CQ) + (size_t)pm * 192 * QRANK * 2;
        B = (const char*)(ws + WS_WUQT) + (size_t)pn * 256 * QRANK * 2; nt = 12; } break;
    case GK_A3KV: { int pm, pn; grid_order(L, 50, 8, pm, pn);
        A = (const char*)(ws + S_CALL) + (size_t)pm * 256 * KVRANK * 2;
        B = (const char*)(ws + WS_WUKVT) + (size_t)pn * 256 * KVRANK * 2; nt = 8; } break;
    case GK_A5: { int pm, pn; grid_order(L, 64, 4, pm, pn);
        A = (const char*)(ws + S_O) + (size_t)pm * 192 * DM * 2;
        B = (const char*)(ws + WS_WOT) + (size_t)pn * 256 * DM * 2; nt = 16; } break;
    default: {
        const int l = L / 32, r = L % 32, gq = r / 8, pm = (r % 8) / 2, pn = r % 2;
        A = (const char*)(ws + WS_WFT) + ((size_t)l * 1024 * 1024 + (size_t)pm * 256 * 1024 + gq * 256) * 2;
        B = (const char*)(ws + WS_C256) + (size_t)pn * 256 * 256 * 2; nt = 4; } break;
    }
}
__device__ __forceinline__ void gate_pair(const unsigned char* ws, int layer, int tok0, int rows, int which, int col0, EUnit& u) {
    u.gate = mod_vec(ws, layer, tok0, which) + col0; u.gate2 = mod_vec(ws, layer, tok0 + rows - 1, which) + col0;
    int rb = rows;
    if (tok0 < NP && tok0 + rows > NP) rb = NP - tok0;
    else if (tok0 >= NP) { const int e = NP + ((tok0 - NP) / SSEQ + 1) * SSEQ; if (tok0 + rows > e) rb = e - tok0; }
    u.i0 = rb;
}
__device__ __forceinline__ void get_epi(const GemmDesc& g, unsigned char* ws, const float* cw, const float* cb, int L, EUnit& u) {
    u.aux = nullptr; u.aux2 = nullptr; u.gate = nullptr; u.gate2 = nullptr; u.o1 = nullptr; u.i0 = u.i1 = u.i2 = u.i3 = 0;
    switch (g.kind) {
    case GK_FFN1: { int pm, pn; grid_order(L, 50, 22, pm, pn); int tok0, p0, T, rlo, rhi; ffn1_tile(pm, tok0, p0, T, rlo, rhi);
        u.o0 = (char*)(ws + S_G) + ((long)tok0 * DFF + 128 * pn) * 2;
        u.aux = cw + (size_t)g.layer * 3 * DFF2 + 128 * pn;
        u.aux2 = cb + (size_t)g.layer * DFF2 + 128 * pn;
        u.i0 = p0; u.i1 = T; u.i2 = rlo; u.i3 = rhi; } break;
    case GK_FFN2: { int pm, pn; grid_order(L, 64, 4, pm, pn);
        u.o0 = (char*)(ws + WS_X) + ((size_t)pm * 192 * DM + pn * 256) * 4; gate_pair(ws, g.layer, pm * 192, 192, 5, pn * 256, u); } break;
    case GK_F1: { int pm, pn; grid_order(L, 8, 48, pm, pn);
        const int part = pm >> 2, n0 = (pm & 3) * 256, tok0 = pn * 256;
        char* zb; int T, s0;
        if (tok0 < NP) { T = PSEQ; s0 = 0; zb = (char*)(ws + S_ZF) + (size_t)(tok0 / PSEQ) * 1024 * 512 * 2; }
        else { T = SSEQ; const int b = (tok0 - NP) / SSEQ; s0 = (tok0 - NP) % SSEQ; zb = (char*)(ws + S_ZF) + (size_t)NPB * 1024 * 512 * 2 + (size_t)b * 1024 * 4096 * 2; }
        u.o0 = zb + ((size_t)n0 * 2 * T + part * T + s0) * 2; u.o1 = u.o0 + 128 * 2; u.i0 = 2 * T; } break;
    case GK_F2S: { const int b = L / 32, mt = (L % 32) / 4, pn = L % 4; const int tok0 = NP + b * SSEQ + mt * 256;
        u.o0 = (char*)(ws + WS_X) + ((size_t)tok0 * DM + pn * 256) * 4; gate_pair(ws, g.layer, tok0, 256, 2, pn * 256, u); } break;
    case GK_F2P: { const int b = L / 4, pn = L % 4; const int tok0 = b * PSEQ;
        u.o0 = (char*)(ws + WS_X) + ((size_t)tok0 * DM + pn * 256) * 4; gate_pair(ws, g.layer, tok0, 256, 2, pn * 256, u); } break;
    case GK_POOL: { int pm, pn; grid_order(L, 64, 4, pm, pn);
        u.o0 = (char*)(ws + WS_X) + ((size_t)pm * 192 * DM + pn * 256) * 4; gate_pair(ws, g.layer, pm * 192, 192, 2, pn * 256, u); } break;
    case GK_A1: { int pm, pn; grid_order(L, 64, 6, pm, pn);
        u.o0 = (char*)(ws + S_RAW) + ((size_t)pm * 192 * NDOWN + pn * 256) * 4; } break;
    case GK_A3Q: { int pm, pn; grid_order(L, 64, 6, pm, pn);
        u.o0 = (char*)(ws + S_QF) + ((size_t)pm * 192 * 1536 + pn * 256) * 2; u.o1 = u.o0 + 128 * 2; } break;
    case GK_A3KV: { int pm, pn; grid_order(L, 50, 8, pm, pn);
        u.o0 = (char*)(ws + S_KF) + ((size_t)pm * 256 * 1536 + pn * QKD) * 2;
        u.o1 = (char*)(ws + S_VF) + ((size_t)pm * 256 * 1024 + pn * VD) * 2; } break;
    case GK_A5: { int pm, pn; grid_order(L, 64, 4, pm, pn);
        u.o0 = (char*)(ws + WS_X) + ((size_t)pm * 192 * DM + pn * 256) * 4; gate_pair(ws, g.layer, pm * 192, 192, 2, pn * 256, u); } break;
    default: { const int l = L / 32, r = L % 32, gq = r / 8, pm = (r % 8) / 2, pn = r % 2;
        u.o0 = (char*)(ws + WS_WCS) + (((size_t)l * 2048 + pn * 1024 + pm * 256) * 1024 + gq * 256) * 2; u.o1 = u.o0 + 128 * 2; } break;
    }
}

typedef f32x4 Acc[2][2][4][2];

__device__ __forceinline__ void epi_xres(const Acc& acc, const EUnit& u, int dry, int mr, int wr, int wc, int fr, int fq) {
    float* X0 = (float*)u.o0; const int cb = wc * 32 + 4 * fq; const float ds = dry ? 0.f : 1.f; const int rb = u.i0;
    f32x4 gv[2][2], gw[2][2];
#pragma unroll
    for (int bj = 0; bj < 2; ++bj)
#pragma unroll
        for (int n = 0; n < 2; ++n) { gv[bj][n] = mod_ld4(u.gate + cb + bj * 128 + n * 16) * ds; gw[bj][n] = mod_ld4(u.gate2 + cb + bj * 128 + n * 16) * ds; }
#pragma unroll
    for (int ai = 0; ai < 2; ++ai)
#pragma unroll
        for (int m = 0; m < 4; ++m) if (m < mr) { const int r = ai * 32 * mr + wr * 16 * mr + m * 16 + fr; float* rowp = X0 + (size_t)r * DM + cb; const bool second = r >= rb;
#pragma unroll
            for (int bj = 0; bj < 2; ++bj)
#pragma unroll
                for (int n = 0; n < 2; ++n) { f32x4* p = (f32x4*)(rowp + bj * 128 + n * 16); const f32x4 xv = *p; const f32x4 gg = second ? gw[bj][n] : gv[bj][n]; *p = xv + gg * acc[ai][bj][m][n]; } }
}
__device__ __forceinline__ void epi_f32(const Acc& acc, const EUnit& u, int ldc, int mr, int wr, int wc, int fr, int fq) {
    float* C0 = (float*)u.o0; const int cb = wc * 32 + 4 * fq;
#pragma unroll
    for (int ai = 0; ai < 2; ++ai)
#pragma unroll
        for (int m = 0; m < 4; ++m) if (m < mr) { float* rowp = C0 + (size_t)(ai * 32 * mr + wr * 16 * mr + m * 16 + fr) * ldc + cb;
#pragma unroll
            for (int bj = 0; bj < 2; ++bj)
#pragma unroll
                for (int n = 0; n < 2; ++n) *(f32x4*)(rowp + bj * 128 + n * 16) = acc[ai][bj][m][n]; }
}
__device__ __forceinline__ void epi_bf16(const Acc& acc, const EUnit& u, int ldc0, int ldc1, int mr, int wr, int wc, int fr, int fq) {
    const int cb = wc * 32 + 8 * fq;
#pragma unroll
    for (int ai = 0; ai < 2; ++ai)
#pragma unroll
        for (int m = 0; m < 4; ++m) if (m < mr) { const int r = ai * 32 * mr + wr * 16 * mr + m * 16 + fr;
#pragma unroll
            for (int bj = 0; bj < 2; ++bj) { bf16_t* dst = (bf16_t*)(bj ? u.o1 : u.o0) + (size_t)r * (bj ? ldc1 : ldc0) + cb;
                const f32x4 v0 = acc[ai][bj][m][0], v1 = acc[ai][bj][m][1];
                u32x4 w; w.x = cvt_pk_bf16(v0[0], v0[1]); w.y = cvt_pk_bf16(v0[2], v0[3]); w.z = cvt_pk_bf16(v1[0], v1[1]); w.w = cvt_pk_bf16(v1[2], v1[3]);
                *(u32x4*)dst = w; } }
}
__device__ __forceinline__ void epi_ffn1(Acc& acc, const EUnit& u, LAS unsigned char* lds, int wr, int wc, int fr, int fq, int lane) {
    const int p0 = u.i0, T = u.i1, rlo = u.i2, rhi = u.i3;
    if (p0 < 0 || p0 + 256 > T) {
#pragma unroll
        for (int ai = 0; ai < 2; ++ai)
#pragma unroll
            for (int m = 0; m < 4; ++m) { const int p = p0 + ai * 128 + wr * 64 + m * 16 + fr; const bool ok = (p >= 0) && (p < T);
#pragma unroll
                for (int bj = 0; bj < 2; ++bj)
#pragma unroll
                    for (int n = 0; n < 2; ++n) { f32x4 v = acc[ai][bj][m][n]; v[0] = ok ? v[0] : 0.f; v[1] = ok ? v[1] : 0.f; v[2] = ok ? v[2] : 0.f; v[3] = ok ? v[3] : 0.f; acc[ai][bj][m][n] = v; } }
    }
    LAS float* XCH = (LAS float*)(lds + XCH_OFF);
    const int cw8 = wc * 32 + 8 * fq;
    if (fr == 0 || fr == 15) {
        const int e = (fr == 15) ? 1 : 0, mm = (fr == 15) ? 3 : 0;
#pragma unroll
        for (int ai = 0; ai < 2; ++ai)
#pragma unroll
            for (int bj = 0; bj < 2; ++bj)
#pragma unroll
                for (int n = 0; n < 2; ++n) {
                    const f32x4 v = (mm == 3) ? acc[ai][bj][3][n] : acc[ai][bj][0][n];
                    *(LAS f32x4*)(XCH + ((2 * ai + wr) * 2 + e) * 256 + bj * 128 + cw8 + 4 * n) = v; }
    }
    asm volatile("s_waitcnt lgkmcnt(0)" ::: "memory"); __builtin_amdgcn_s_barrier(); asm volatile("" ::: "memory");
    const int srcUp = (lane & 48) | ((lane - 1) & 15), srcDn = (lane & 48) | ((lane + 1) & 15);
    const float* wcv = u.aux; const float* bcv = u.aux2;
    unsigned packed[2][4][4];
#pragma unroll
    for (int n = 0; n < 2; ++n) {
        const int cc = cw8 + 4 * n;
        const f32x4 w0g = *(const f32x4*)(wcv + cc), w1g = *(const f32x4*)(wcv + DFF2 + cc), w2g = *(const f32x4*)(wcv + 2 * DFF2 + cc), bg = *(const f32x4*)(bcv + cc);
        const f32x4 w0v = *(const f32x4*)(wcv + DFF + cc), w1v = *(const f32x4*)(wcv + DFF2 + DFF + cc), w2v = *(const f32x4*)(wcv + 2 * DFF2 + DFF + cc), bv = *(const f32x4*)(bcv + DFF + cc);
#pragma unroll
        for (int ai = 0; ai < 2; ++ai) {
            const int q = 2 * ai + wr;
            f32x4 htop[2], hbot[2];
#pragma unroll
            for (int bj = 0; bj < 2; ++bj) {
                htop[bj] = (q > 0) ? *(const LAS f32x4*)(XCH + ((q - 1) * 2 + 1) * 256 + bj * 128 + cc) : (f32x4){0.f, 0.f, 0.f, 0.f};
                hbot[bj] = (q < 3) ? *(const LAS f32x4*)(XCH + ((q + 1) * 2 + 0) * 256 + bj * 128 + cc) : (f32x4){0.f, 0.f, 0.f, 0.f};
            }
#pragma unroll
            for (int m = 0; m < 4; ++m) {
                f32x4 uu[2];
#pragma unroll
                for (int bj = 0; bj < 2; ++bj) {
                    const f32x4 cur = acc[ai][bj][m][n];
                    const f32x4 prv = (m > 0) ? acc[ai][bj][m > 0 ? m - 1 : 0][n] : cur;
                    const f32x4 nxt = (m < 3) ? acc[ai][bj][m < 3 ? m + 1 : 3][n] : cur;
                    f32x4 up, dn;
#pragma unroll
                    for (int e = 0; e < 4; ++e) {
                        const float su = (fr == 15) ? prv[e] : cur[e];
                        const float sd = (fr == 0) ? nxt[e] : cur[e];
                        up[e] = lane_shfl(su, srcUp); dn[e] = lane_shfl(sd, srcDn);
                    }
                    if (m == 0) { up[0] = (fr == 0) ? htop[bj][0] : up[0]; up[1] = (fr == 0) ? htop[bj][1] : up[1]; up[2] = (fr == 0) ? htop[bj][2] : up[2]; up[3] = (fr == 0) ? htop[bj][3] : up[3]; }
                    if (m == 3) { dn[0] = (fr == 15) ? hbot[bj][0] : dn[0]; dn[1] = (fr == 15) ? hbot[bj][1] : dn[1]; dn[2] = (fr == 15) ? hbot[bj][2] : dn[2]; dn[3] = (fr == 15) ? hbot[bj][3] : dn[3]; }
                    const f32x4 w0 = bj ? w0v : w0g, w1 = bj ? w1v : w1g, w2 = bj ? w2v : w2g, bb = bj ? bv : bg;
                    uu[bj] = w0 * up + w1 * cur + w2 * dn + bb;
                }
                f32x4 o;
#pragma unroll
                for (int e = 0; e < 4; ++e) { const float gt = uu[0][e]; o[e] = gt * __builtin_amdgcn_rcpf(1.0f + __expf(-gt)) * uu[1][e]; }
                packed[ai][m][2 * n] = cvt_pk_bf16(o[0], o[1]); packed[ai][m][2 * n + 1] = cvt_pk_bf16(o[2], o[3]);
            }
        }
    }
    bf16_t* G0 = (bf16_t*)u.o0;
#pragma unroll
    for (int ai = 0; ai < 2; ++ai)
#pragma unroll
        for (int m = 0; m < 4; ++m) { const int r = ai * 128 + wr * 64 + m * 16 + fr;
            if (r >= rlo && r < rhi) { u32x4 w; w.x = packed[ai][m][0]; w.y = packed[ai][m][1]; w.z = packed[ai][m][2]; w.w = packed[ai][m][3];
                *(u32x4*)(G0 + (long)r * DFF + cw8) = w; } }
}

__device__ __forceinline__ void gemm_phase(LAS unsigned char* lds, const GemmDesc& g, unsigned char* ws, const float* cw, const float* cb, int wave, int G, int c) {
    using namespace pg8;
    asm volatile("" : "+s"(ws));
    const int lane = fresh_lane(), wid = wave, tid = wid * 64 + lane, wr = wid >> 2, wc = wid & 3, fr = lane & 15, fq = lane >> 4;
    if (c >= g.total) return;
    unsigned voffA, voffB;
    { int R, C; stage_rc(tid * 16, R, C); const int Rb = g.perm ? ((R & ~31) + perm32(R & 31)) : R;
      const int Ra = (g.mr == 3) ? (48 * (R >> 6) + ((R & 63) < 48 ? (R & 63) : 47)) : R;
      voffA = (unsigned)(Ra * g.lda + C) * 2u; voffB = (unsigned)(Rb * g.ldb + C) * 2u; }
    const size_t pieceA = (size_t)(g.mr == 3 ? 48 : 64) * g.lda * 2, pieceB = (size_t)64 * g.ldb * 2;
    const size_t kstep = (size_t)(BK * 2);
    const size_t hsA = (size_t)g.hsA, hsB = (size_t)g.hsB;
    const unsigned ldsw = (unsigned)wid * 1024u;
    const int aoff = lds_byte(wr * 64 + fr, fq * 8), boff = lds_byte(wc * 32 + fr, fq * 8);
    const bool pfA = wid < 4;
    unsigned pfoff;
    { const int prow = (wid & 3) * 64 + lane, ph = prow >> 7, pR = prow & 127;
      const int pRa = (g.mr == 3) ? (48 * (pR >> 6) + ((pR & 63) < 48 ? (pR & 63) : 47)) : pR;
      pfoff = pfA ? (unsigned)(ph * g.hsA + pRa * g.lda * 2) : (unsigned)(ph * g.hsB + pR * g.ldb * 2); }
#define PG8_PF(tp) do { if (PF_DIST > 0) { const int _tp = (tp); const char* _b = (_tp < nt) ? ((pfA ? cA : cB) + (size_t)_tp * kstep) : (has_next ? ((pfA ? nA : nB) + (size_t)(_tp - nt) * kstep) : (pfA ? cA : cB)); \
        __builtin_amdgcn_global_load_lds((const unsigned*)(_b + pfoff), (LAS unsigned*)(lds + PF_OFF + wid * 256), 4, 0, 0); } } while (0)
#define PG8_SA(b, h) (((b) * 2 + (h)) * HTB)
#define PG8_SB(b, h) ((4 + (b) * 2 + (h)) * HTB)
#define PG8_STAGE(bufoff, gbase, voff) do { _Pragma("unroll") for (int _i = 0; _i < 2; ++_i) \
        __builtin_amdgcn_global_load_lds((const unsigned*)((const char*)(gbase) + (_i ? piece_##voff : (size_t)0) + (voff)), (LAS unsigned*)(lds + (bufoff) + ldsw + _i * 8192), 16, 0, 0); } while (0)
#define piece_voffA pieceA
#define piece_voffB pieceB
#define PG8_LDA(dst, b, h) do { _Pragma("unroll") for (int m = 0; m < 4; ++m) if (m < g.mr) _Pragma("unroll") for (int k = 0; k < 2; ++k) dst[m][k] = *(const LAS bf16x8*)(lds + PG8_SA(b, h) + aoff + m * 2048 + k * 1024); } while (0)
#define PG8_LDB(dst, b, h) do { _Pragma("unroll") for (int n = 0; n < 2; ++n) _Pragma("unroll") for (int k = 0; k < 2; ++k) dst[n][k] = *(const LAS bf16x8*)(lds + PG8_SB(b, h) + boff + n * 2048 + k * 1024); } while (0)
#define PG8_MMA(ai, bj, At, Bt) do { __builtin_amdgcn_s_setprio(1); _Pragma("unroll") for (int m = 0; m < 4; ++m) if (m < g.mr) _Pragma("unroll") for (int n = 0; n < 2; ++n) _Pragma("unroll") for (int k = 0; k < 2; ++k) \
        acc[ai][bj][m][n] = __builtin_amdgcn_mfma_f32_16x16x32_bf16(Bt[n][k], At[m][k], acc[ai][bj][m][n], 0, 0, 0); __builtin_amdgcn_s_setprio(0); } while (0)
#define PG8_WAIT_V(n) asm volatile("s_waitcnt vmcnt(" #n ")" ::: "memory")
#define PG8_WAIT_VK do { if (PF_DIST > 0) PG8_WAIT_V(9); else PG8_WAIT_V(8); } while (0)
#define PG8_WAIT_L(n) asm volatile("s_waitcnt lgkmcnt(" #n ")" ::: "memory")
#define PG8_BAR __builtin_amdgcn_s_barrier()
#define PG8_SCHED __builtin_amdgcn_sched_barrier(0)
    int L = c, nt;
    const char* cA; const char* cB;
    get_ab(g, ws, L, cA, cB, nt);
    Acc acc;
#pragma unroll
    for (int a = 0; a < 2; ++a)
#pragma unroll
        for (int b = 0; b < 2; ++b)
#pragma unroll
            for (int m = 0; m < 4; ++m)
#pragma unroll
                for (int n = 0; n < 2; ++n) acc[a][b][m][n] = (f32x4){0.f, 0.f, 0.f, 0.f};
    bf16x8 At[4][2], B0[2][2], B1[2][2];
    PG8_STAGE(PG8_SB(0, 0), cB, voffB); PG8_STAGE(PG8_SB(0, 1), cB + hsB, voffB); PG8_STAGE(PG8_SA(0, 0), cA, voffA); PG8_STAGE(PG8_SA(0, 1), cA + hsA, voffA);
    if (wr == 1) PG8_BAR;
    PG8_WAIT_V(2); PG8_BAR;
    PG8_STAGE(PG8_SB(1, 0), cB + kstep, voffB); PG8_STAGE(PG8_SA(1, 0), cA + kstep, voffA); PG8_STAGE(PG8_SB(1, 1), cB + hsB + kstep, voffB);
    PG8_WAIT_V(6); PG8_BAR;
    for (;;) {
        const bool has_next = (L + G) < g.total;
        const char* nA = cA; const char* nB = cB; int nnt = nt;
        if (has_next) get_ab(g, ws, L + G, nA, nB, nnt);
        for (int t = 0; t < nt; t += 2) {
            const bool last = (t == nt - 2);
            const char* a1 = cA + (size_t)(t + 1) * kstep;
            const char* a2 = last ? nA : cA + (size_t)(t + 2) * kstep; const char* b2 = last ? nB : cB + (size_t)(t + 2) * kstep;
            const char* a3 = a2 + kstep; const char* b3 = b2 + kstep;
            PG8_LDB(B0, 0, 0); PG8_LDB(B1, 0, 1); PG8_SCHED; PG8_LDA(At, 0, 0); PG8_STAGE(PG8_SA(1, 1), a1 + hsA, voffA); PG8_PF(t + PF_DIST);
            PG8_WAIT_VK; PG8_WAIT_L(0); PG8_BAR; PG8_MMA(0, 0, At, B0); PG8_MMA(0, 1, At, B1); PG8_BAR; PG8_SCHED;
            PG8_LDA(At, 0, 1); PG8_STAGE(PG8_SB(0, 0), b2, voffB); PG8_STAGE(PG8_SB(0, 1), b2 + hsB, voffB); PG8_STAGE(PG8_SA(0, 0), a2, voffA);
            PG8_WAIT_VK; PG8_WAIT_L(0); PG8_BAR; PG8_MMA(1, 0, At, B0); PG8_MMA(1, 1, At, B1); PG8_BAR; PG8_SCHED;
            PG8_LDB(B0, 1, 0); PG8_LDB(B1, 1, 1); PG8_SCHED; PG8_LDA(At, 1, 0); PG8_STAGE(PG8_SA(0, 1), a2 + hsA, voffA); PG8_PF(t + 1 + PF_DIST);
            PG8_WAIT_VK; PG8_WAIT_L(0); PG8_BAR; PG8_MMA(0, 0, At, B0); PG8_MMA(0, 1, At, B1); PG8_BAR; PG8_SCHED;
            PG8_LDA(At, 1, 1); PG8_STAGE(PG8_SB(1, 0), b3, voffB); PG8_STAGE(PG8_SB(1, 1), b3 + hsB, voffB); PG8_STAGE(PG8_SA(1, 0), a3, voffA);
            PG8_WAIT_VK; PG8_WAIT_L(0); PG8_BAR; PG8_MMA(1, 0, At, B0); PG8_MMA(1, 1, At, B1); PG8_BAR; PG8_SCHED;
        }
        if (wr == 0) PG8_BAR;
        { EUnit eu; get_epi(g, ws, cw, cb, L, eu);
          int efr = fr, efq = fq, elane = lane; asm volatile("" : "+v"(efr), "+v"(efq), "+v"(elane));
          switch (g.epi) {
          case EK_XRES: epi_xres(acc, eu, g.dry, g.mr, wr, wc, efr, efq); break;
          case EK_BF16: epi_bf16(acc, eu, g.kind == GK_F1 ? eu.i0 : g.ldc0, g.kind == GK_F1 ? eu.i0 : g.ldc1, g.mr, wr, wc, efr, efq); break;
          case EK_F32: epi_f32(acc, eu, g.ldc0, g.mr, wr, wc, efr, efq); break;
          default: epi_ffn1(acc, eu, lds, wr, wc, efr, efq, elane); break;
          } }
        if (!has_next) break;
#pragma unroll
        for (int a = 0; a < 2; ++a)
#pragma unroll
            for (int b = 0; b < 2; ++b)
#pragma unroll
                for (int m = 0; m < 4; ++m)
#pragma unroll
                    for (int n = 0; n < 2; ++n) acc[a][b][m][n] = (f32x4){0.f, 0.f, 0.f, 0.f};
        L += G; cA = nA; cB = nB; nt = nnt;
        if (wr == 1) PG8_BAR;
    }
    PG8_WAIT_V(0);
    PG8_BAR;
#undef PG8_SA
#undef PG8_SB
#undef PG8_STAGE
#undef piece_voffA
#undef piece_voffB
#undef PG8_LDA
#undef PG8_LDB
#undef PG8_MMA
#undef PG8_WAIT_V
#undef PG8_WAIT_VK
#undef PG8_PF
#undef PG8_WAIT_L
#undef PG8_BAR
#undef PG8_SCHED
}


__device__ __forceinline__ unsigned char* opaque_ptr(unsigned char* p) { asm volatile("" : "+s"(p)); return p; }
struct Frame {
    LAS unsigned char* lds; unsigned char* ws; float* out;
    int wave, vcu, G, gw, ngw;
};

__device__ __forceinline__ void pass_modulate(Frame& F, int layer, int which) {
    unsigned char* const wsp = opaque_ptr(F.ws);
    const int lane = fresh_lane(), tid = F.wave * 64 + lane; (void)tid;
    const float* X = (const float*)(wsp + WS_X); bf16_t* H = (bf16_t*)(wsp + WS_H);
    constexpr int R = 3;
    for (int tok0 = F.gw; tok0 < NTOK; tok0 += R * F.ngw) {
        f32x4 v[R][4]; float s[R];
#pragma unroll
        for (int r = 0; r < R; ++r) { const int tok = tok0 + r * F.ngw; s[r] = 0.f;
            if (tok < NTOK) { const f32x4* xr = (const f32x4*)(X + (size_t)tok * DM) + lane;
#pragma unroll
                for (int j = 0; j < 4; ++j) v[r][j] = xr[64 * j]; } }
#pragma unroll
        for (int r = 0; r < R; ++r) { const int tok = tok0 + r * F.ngw;
            if (tok < NTOK) {
#pragma unroll
                for (int j = 0; j < 4; ++j) s[r] += (v[r][j].x * v[r][j].x + v[r][j].y * v[r][j].y) + (v[r][j].z * v[r][j].z + v[r][j].w * v[r][j].w);
                const float rstd = 1.0f / sqrtf(wave_sum(s[r], lane) * (1.0f / DM) + EPS);
                const modacc_t* sh = mod_vec(wsp, layer, tok, which) + 4 * lane;
                const modacc_t* sc = mod_vec(wsp, layer, tok, which + 1) + 4 * lane;
                u32x2* o8 = (u32x2*)(H + (size_t)tok * DM) + lane;
#pragma unroll
                for (int j = 0; j < 4; ++j) { const f32x4 a = mod_ld4(sh + 256 * j), b = mod_ld4(sc + 256 * j); const f32x4 h = v[r][j] * rstd * (b + 1.0f) + a;
                    u32x2 w; w.x = pk2(h.x, h.y); w.y = pk2(h.z, h.w); o8[64 * j] = w; } } }
    }
}
__device__ __forceinline__ void pass_final(Frame& F, const Args& A) {
    unsigned char* const wsp = opaque_ptr(F.ws);
    const int lane = fresh_lane(), tid = F.wave * 64 + lane; (void)tid;
    const float* X = (const float*)(wsp + WS_X); const float* gf = A.in[22];
    constexpr int R = 3;
    f32x4 g[4];
#pragma unroll
    for (int j = 0; j < 4; ++j) g[j] = ((const f32x4*)gf)[lane + 64 * j];
    for (int tok0 = F.gw; tok0 < NTOK; tok0 += R * F.ngw) {
        f32x4 v[R][4];
#pragma unroll
        for (int r = 0; r < R; ++r) { const int tok = tok0 + r * F.ngw;
            if (tok < NTOK) { const f32x4* xr = (const f32x4*)(X + (size_t)tok * DM) + lane;
#pragma unroll
                for (int j = 0; j < 4; ++j) v[r][j] = xr[64 * j]; } }
#pragma unroll
        for (int r = 0; r < R; ++r) { const int tok = tok0 + r * F.ngw;
            if (tok < NTOK) { float s = 0.f;
#pragma unroll
                for (int j = 0; j < 4; ++j) s += (v[r][j].x * v[r][j].x + v[r][j].y * v[r][j].y) + (v[r][j].z * v[r][j].z + v[r][j].w * v[r][j].w);
                const float rstd = 1.0f / sqrtf(wave_sum(s, lane) * (1.0f / DM) + EPS);
                f32x4* o = (f32x4*)(F.out + (size_t)tok * DM) + lane;
#pragma unroll
                for (int j = 0; j < 4; ++j) o[64 * j] = v[r][j] * rstd * g[j]; } }
    }
}
__device__ __forceinline__ void pass_pool(Frame& F) {
    unsigned char* const wsp = opaque_ptr(F.ws);
    const int lane = fresh_lane(), tid = F.wave * 64 + lane; (void)tid;
    const bf16_t* H = (const bf16_t*)(wsp + WS_H); bf16_t* PL = (bf16_t*)(wsp + S_PL);
    for (int tok = F.gw; tok < NTOK; tok += F.ngw) {
        int base, T, t;
        if (tok < NP) { base = tok & ~(PSEQ - 1); T = PSEQ; t = tok - base; } else { const int r = tok - NP; base = NP + (r & ~(SSEQ - 1)); T = SSEQ; t = tok - base; }
#pragma unroll
        for (int j = 0; j < 4; ++j) {
            constexpr int dummy = 0; (void)dummy;
            const int w = 2 << j;
            float s0 = 0.f, s1 = 0.f, s2 = 0.f, s3 = 0.f, c0 = 0.f, c1 = 0.f, c2 = 0.f, c3 = 0.f; int cnt = 0;
#pragma unroll
            for (int d = 0; d < w; ++d) {
                const int tt = t - w / 2 + d; const bool ok = (tt >= 0) && (tt < T); const int tc = ok ? tt : t;
                const u32x2 q = *((const u32x2*)(H + (size_t)(base + tc) * DM + 256 * j) + lane);
                const float f0 = __builtin_bit_cast(float, q.x << 16), f1 = __builtin_bit_cast(float, q.x & 0xffff0000u), f2 = __builtin_bit_cast(float, q.y << 16), f3 = __builtin_bit_cast(float, q.y & 0xffff0000u);
                s0 += ok ? f0 : 0.f; s1 += ok ? f1 : 0.f; s2 += ok ? f2 : 0.f; s3 += ok ? f3 : 0.f; cnt += ok ? 1 : 0;
                if (d == w / 2) { c0 = f0; c1 = f1; c2 = f2; c3 = f3; }
            }
            const float inv = 1.0f / (float)cnt;
            u32x2 w2; w2.x = pk2(s0 * inv - c0, s1 * inv - c1); w2.y = pk2(s2 * inv - c2, s3 * inv - c3);
            *((u32x2*)(PL + (size_t)tok * DM + 256 * j) + lane) = w2;
        }
    }
}
__device__ __forceinline__ void pass_mla_norm(Frame& F, const Args& A) {
    unsigned char* const wsp = opaque_ptr(F.ws);
    const int lane = fresh_lane(), tid = F.wave * 64 + lane; (void)tid;
    const float* RAW = (const float*)(wsp + S_RAW); bf16_t* CQ = (bf16_t*)(wsp + S_CQ); bf16_t* CALL = (bf16_t*)(wsp + S_CALL); bf16_t* KF = (bf16_t*)(wsp + S_KF);
    const float* gq = A.in[12]; const float* gkv = A.in[15];
    float* st_ckv = F.out + (size_t)NTOK * DM; float* st_kpe = st_ckv + (size_t)NP * KVRANK;
    constexpr int R = 3;
    for (int tok0 = F.gw; tok0 < NTOK; tok0 += R * F.ngw) {
        f32x4 vq[R][3], vk[R][2]; float xp[R];
#pragma unroll
        for (int r = 0; r < R; ++r) { const int tok = tok0 + r * F.ngw;
            if (tok < NTOK) { const float* rr = RAW + (size_t)tok * NDOWN;
#pragma unroll
                for (int j = 0; j < 3; ++j) vq[r][j] = ((const f32x4*)rr)[lane + 64 * j];
#pragma unroll
                for (int j = 0; j < 2; ++j) vk[r][j] = ((const f32x4*)(rr + QRANK))[lane + 64 * j];
                xp[r] = rr[QRANK + KVRANK + lane]; } }
#pragma unroll
        for (int r = 0; r < R; ++r) { const int tok = tok0 + r * F.ngw;
            if (tok < NTOK) {
                int krow; if (tok < NP) krow = tok; else { const int rs = tok - NP; krow = NP + (rs / SSEQ) * SKV + PAST + (rs % SSEQ); }
                { float s = 0.f;
#pragma unroll
                  for (int j = 0; j < 3; ++j) s += (vq[r][j].x * vq[r][j].x + vq[r][j].y * vq[r][j].y) + (vq[r][j].z * vq[r][j].z + vq[r][j].w * vq[r][j].w);
                  const float rstd = 1.0f / sqrtf(wave_sum(s, lane) * (1.0f / QRANK) + EPS);
#pragma unroll
                  for (int j = 0; j < 3; ++j) { const f32x4 g = ((const f32x4*)gq)[lane + 64 * j]; const f32x4 h = vq[r][j] * rstd * g; u32x2 w; w.x = pk2(h.x, h.y); w.y = pk2(h.z, h.w);
                      *((u32x2*)(CQ + (size_t)tok * QRANK) + lane + 64 * j) = w; } }
                { float s = 0.f;
#pragma unroll
                  for (int j = 0; j < 2; ++j) s += (vk[r][j].x * vk[r][j].x + vk[r][j].y * vk[r][j].y) + (vk[r][j].z * vk[r][j].z + vk[r][j].w * vk[r][j].w);
                  const float rstd = 1.0f / sqrtf(wave_sum(s, lane) * (1.0f / KVRANK) + EPS);
#pragma unroll
                  for (int j = 0; j < 2; ++j) { const f32x4 g = ((const f32x4*)gkv)[lane + 64 * j]; const f32x4 h = vk[r][j] * rstd * g; u32x2 w; w.x = pk2(h.x, h.y); w.y = pk2(h.z, h.w);
                      *((u32x2*)(CALL + (size_t)krow * KVRANK) + lane + 64 * j) = w;
                      if (tok < NP) ((f32x4*)(st_ckv + (size_t)tok * KVRANK))[lane + 64 * j] = h; } }
                { float x = xp[r];
                  if (tok < NP) { st_kpe[(size_t)tok * ROPE + lane] = x; }
                  else { const int t = (tok - NP) % SSEQ; const int pos = (lane < 32) ? (t >> 6) : (t & 63);
                      const float inv = __builtin_amdgcn_exp2f(-(float)(lane & 15) * 0.8304820237218407f);
                      const float rev = (float)pos * inv * 0.15915494309189535f;
                      const float cs = __builtin_amdgcn_cosf(rev), sn = __builtin_amdgcn_sinf(rev);
                      const float partner = lane_shfl(x, lane ^ 16);
                      x = (lane & 16) ? (x * cs + partner * sn) : (x * cs - partner * sn); }
                  const bf16_t xb = (bf16_t)f2bf(x);
#pragma unroll
                  for (int h = 0; h < NHEAD; ++h) KF[(size_t)krow * 1536 + h * QKD + 128 + lane] = xb; } } }
    }
}

__device__ __forceinline__ void xpose_item(const float* W, int N, bf16_t* WT, int ldk, const float* rscale, LAS float* scr, int item, int lane) {
    const int nblk = N / 32, kb = item / nblk, nb = item % nblk, k0 = 64 * kb, n0 = 32 * nb;
#pragma unroll 8
    for (int i = 0; i < 32; ++i) { const int kk = 2 * i + (lane >> 5); scr[kk * 33 + (lane & 31)] = W[(size_t)(k0 + kk) * N + n0 + (lane & 31)]; }
    asm volatile("s_waitcnt lgkmcnt(0)" ::: "memory");
    const int c = lane & 7;
#pragma unroll
    for (int j = 0; j < 4; ++j) { const int n = (lane >> 3) + 8 * j; const LAS float* s = scr + (8 * c) * 33 + n; const float sc = rscale ? rscale[n0 + n] : 1.0f;
        u32x4 o; o.x = pk2(s[0 * 33] * sc, s[1 * 33] * sc); o.y = pk2(s[2 * 33] * sc, s[3 * 33] * sc); o.z = pk2(s[4 * 33] * sc, s[5 * 33] * sc); o.w = pk2(s[6 * 33] * sc, s[7 * 33] * sc);
        *(u32x4*)(WT + (size_t)(n0 + n) * ldk + k0 + 8 * c) = o; }
    asm volatile("s_waitcnt lgkmcnt(0)" ::: "memory");
}
struct XJob { const float* W; int K, N; bf16_t* WT; int ldk; const float* rscale; int items; };
__device__ __forceinline__ XJob xjob(Frame& F, const Args& A, int j) {
    XJob x; x.rscale = nullptr; unsigned char* ws = opaque_ptr(F.ws);
    if (j < 2)       { x.W = A.in[8] + (size_t)j * 1024 * 1024; x.K = 1024; x.N = 1024; x.WT = (bf16_t*)(ws + WS_WFT) + (size_t)j * 1024 * 1024; }
    else if (j < 6)  { const int g = j - 2; x.W = A.in[9] + (size_t)g * 256 * 256; x.K = 256; x.N = 256; x.WT = (bf16_t*)(ws + WS_WPT) + (size_t)g * 256 * 256; x.rscale = A.in[10] + g * 256; }
    else if (j == 6) { x.W = A.in[11]; x.K = 1024; x.N = 768; x.WT = (bf16_t*)(ws + WS_WDT); }
    else if (j == 7) { x.W = A.in[14]; x.K = 1024; x.N = 576; x.WT = (bf16_t*)(ws + WS_WDT) + (size_t)768 * 1024; }
    else if (j == 8) { x.W = A.in[13]; x.K = 768; x.N = 1536; x.WT = (bf16_t*)(ws + WS_WUQT); }
    else if (j == 9) { x.W = A.in[16]; x.K = 512; x.N = 2048; x.WT = (bf16_t*)(ws + WS_WUKVT); }
    else if (j == 10) { x.W = A.in[17]; x.K = 1024; x.N = 1024; x.WT = (bf16_t*)(ws + WS_WOT); }
    else if (j < 15) { const int l = j - 11; x.W = A.in[18] + (size_t)l * 1024 * DFF2; x.K = 1024; x.N = DFF2; x.WT = (bf16_t*)(ws + WS_WIN) + (size_t)l * DFF2 * 1024; }
    else             { const int l = j - 15; x.W = A.in[21] + (size_t)l * DFF * 1024; x.K = DFF; x.N = 1024; x.WT = (bf16_t*)(ws + WS_WOUT) + (size_t)l * 1024 * DFF; }
    x.ldk = x.K; x.items = (x.K / 64) * (x.N / 32);
    return x;
}
__device__ __forceinline__ void p0_prologue(Frame& F, const Args& A) {
    const int lane = fresh_lane(), tid = F.wave * 64 + lane; (void)tid;
    unsigned char* ws = opaque_ptr(F.ws);
    { const f32x4* s0 = (const f32x4*)A.in[0]; const f32x4* s1 = (const f32x4*)A.in[1]; f32x4* d = (f32x4*)(ws + WS_X);
      const size_t n0 = (size_t)NP * DM / 4, n1 = (size_t)NS * DM / 4, stride = (size_t)F.G * 512;
      for (size_t i = (size_t)F.vcu * 512 + tid; i < n0 + n1; i += stride) d[i] = (i < n0) ? s0[i] : s1[i - n0]; }
    { const int gt = F.vcu * 512 + tid;
      if (gt < 4 * 16 * 1536) {
          const int layer = gt / (16 * 1536), rem = gt % (16 * 1536), kr = rem / 1536, c4 = rem % 1536;
          const float* W = A.in[6] + (size_t)layer * 1024 * 6144 + (size_t)kr * 64 * 6144 + c4 * 4;
          const float* cc = A.in[5]; const float* c0 = A.in[4]; const float* c1 = A.in[4] + 1024;
          f32x4 a0 = {0.f, 0.f, 0.f, 0.f}, a1 = a0, a2 = a0;
#pragma unroll 8
          for (int k = 0; k < 64; ++k) { const f32x4 w = *(const f32x4*)(W + (size_t)k * 6144); const int kk = kr * 64 + k;
              a0 += w * silu_f(cc[kk]); a1 += w * silu_f(c0[kk]); a2 += w * silu_f(c1[kk]); }
          if (kr == 0) { const f32x4 b = *(const f32x4*)(A.in[7] + (size_t)layer * 6144 + c4 * 4); a0 += b; a1 += b; a2 += b; }
          unsigned long long* M = (unsigned long long*)(ws + WS_CTL + CTL_MOD_OFF) + (size_t)layer * 3 * 6144 + c4 * 4;
#pragma unroll
          for (int e = 0; e < 4; ++e) {
              atomicAdd(M + e, (unsigned long long)(long long)rintf(a0[e] * 4294967296.0f)); atomicAdd(M + 6144 + e, (unsigned long long)(long long)rintf(a1[e] * 4294967296.0f));
              atomicAdd(M + 2 * 6144 + e, (unsigned long long)(long long)rintf(a2[e] * 4294967296.0f)); }
      } }
    { LAS float* scr = (LAS float*)(F.lds + F.wave * 16384);
      int base = 0;
      for (int j = 0; j < 19; ++j) { const XJob x = xjob(F, A, j);
          int it = F.gw - (base % F.ngw); if (it < 0) it += F.ngw;
          for (; it < x.items; it += F.ngw) xpose_item(x.W, x.N, x.WT, x.ldk, x.rscale, scr, it, lane);
          base += x.items; } }
    { u32x4* d = (u32x4*)((bf16_t*)(ws + WS_WDT) + (size_t)1344 * 1024); const size_t n = (size_t)192 * 1024 * 2 / 16;
      for (size_t i = (size_t)F.vcu * 512 + tid; i < n; i += (size_t)F.G * 512) d[i] = (u32x4){0u, 0u, 0u, 0u}; }
    { bf16_t* ds = (bf16_t*)(ws + WS_DFTS); const size_t n = (size_t)SSEQ * 2 * SSEQ / 2; const float sc = 0.022097086912079608f;
      for (size_t i = (size_t)F.vcu * 512 + tid; i < n; i += (size_t)F.G * 512) { const int t = (int)(i / SSEQ); const int k2 = (int)(i % SSEQ) * 2; float v[2];
#pragma unroll
          for (int e = 0; e < 2; ++e) { const int kk = k2 + e; const int s = kk & (SSEQ - 1); const float rev = (float)((t * s) & (SSEQ - 1)) * (1.0f / SSEQ);
              v[e] = (kk < SSEQ) ? __builtin_amdgcn_cosf(rev) * sc : -__builtin_amdgcn_sinf(rev) * sc; }
          ((unsigned*)ds)[i] = pk2(v[0], v[1]); }
      bf16_t* dp = (bf16_t*)(ws + WS_DFTP); const size_t np = (size_t)PSEQ * 2 * PSEQ / 2;
      for (size_t i = (size_t)F.vcu * 512 + tid; i < np; i += (size_t)F.G * 512) { const int t = (int)(i / PSEQ); const int k2 = (int)(i % PSEQ) * 2; float v[2];
#pragma unroll
          for (int e = 0; e < 2; ++e) { const int kk = k2 + e; const int s = kk & (PSEQ - 1); const float rev = (float)((t * s) & (PSEQ - 1)) * (1.0f / PSEQ);
              v[e] = (kk < PSEQ) ? __builtin_amdgcn_cosf(rev) * 0.0625f : -__builtin_amdgcn_sinf(rev) * 0.0625f; }
          ((unsigned*)dp)[i] = pk2(v[0], v[1]); }
      bf16_t* dc = (bf16_t*)(ws + WS_C256); const size_t nc = (size_t)512 * 256 / 2;
      for (size_t i = (size_t)F.vcu * 512 + tid; i < nc; i += (size_t)F.G * 512) { const int r = (int)(i / 128); const int j2 = (int)(i % 128) * 2; float v[2];
#pragma unroll
          for (int e = 0; e < 2; ++e) { const int j = j2 + e; const float rev = (float)(((r & 255) * j) & 255) * (1.0f / 256.0f);
              v[e] = (r < 256) ? __builtin_amdgcn_cosf(rev) * 0.0625f : __builtin_amdgcn_sinf(rev) * 0.0625f; }
          ((unsigned*)dc)[i] = pk2(v[0], v[1]); } }
    { const float* cc = A.in[2]; const float* ck = A.in[3]; bf16_t* CALL = (bf16_t*)(ws + S_CALL); bf16_t* KF = (bf16_t*)(ws + S_KF);
      for (int r = F.gw; r < NSB * PAST; r += F.ngw) { const int b = r / PAST, j = r % PAST; const int krow = NP + b * SKV + j;
#pragma unroll
          for (int q = 0; q < 2; ++q) { const f32x4 v = ((const f32x4*)(cc + (size_t)r * KVRANK))[lane + 64 * q]; u32x2 w; w.x = pk2(v.x, v.y); w.y = pk2(v.z, v.w);
              *((u32x2*)(CALL + (size_t)krow * KVRANK) + lane + 64 * q) = w; }
          const bf16_t xb = (bf16_t)f2bf(ck[(size_t)r * ROPE + lane]);
#pragma unroll
          for (int h = 0; h < NHEAD; ++h) KF[(size_t)krow * 1536 + h * QKD + 128 + lane] = xb; } }
}

namespace att {
constexpr int KVBLK = 64, QBLK = 32;
constexpr int SHM_V = KVBLK * VD * 2, SHM_K = KVBLK * QKD * 2;
constexpr int SHM_ATTN = 2 * SHM_V + 2 * SHM_K + 8 * 64 * 4;
constexpr int LDQ = 1536, LDK = 1536, LDV = 1024, LDO = 1024;
constexpr float THR = 8.f;
#define KSWZ(row, colB) ((row) * 384 + ((colB) ^ (((row) & 7) << 4)))
#define SBAR() __builtin_amdgcn_sched_barrier(0)
__device__ __forceinline__ int crow(int r, int hi) { return (r & 3) + 8 * (r >> 2) + 4 * hi; }
__device__ __forceinline__ void partialSM(f32x16& p0, f32x16& p1, float& m_reg, float& mn, float& alpha) {
  constexpr float C = SM_SCALE * 1.4426950408889634f;
  float pmax = p0[0];
#pragma unroll
  for (int r = 1; r < 16; ++r) pmax = fmaxf(pmax, p0[r]);
#pragma unroll
  for (int r = 0; r < 16; ++r) pmax = fmaxf(pmax, p1[r]);
  { auto rr = __builtin_amdgcn_permlane32_swap(__float_as_uint(pmax), __float_as_uint(pmax), false, false);
    pmax = fmaxf(__uint_as_float(rr[0]), __uint_as_float(rr[1])); }
  if (__builtin_expect(__all(pmax - m_reg <= THR / SM_SCALE), 1)) { mn = m_reg; alpha = 1.f; }
  else { mn = fmaxf(m_reg, pmax); alpha = __builtin_amdgcn_exp2f((m_reg - mn) * C); m_reg = mn; }
  float mnC = -mn * C;
#pragma unroll
  for (int r = 0; r < 16; ++r) p0[r] = fmaf(p0[r], C, mnC);
#pragma unroll
  for (int r = 0; r < 16; ++r) p1[r] = fmaf(p1[r], C, mnC);
#pragma unroll
  for (int r = 0; r < 16; ++r) p0[r] = __builtin_amdgcn_exp2f(p0[r]);
}
__device__ __forceinline__ void finishSM(f32x16& p0, f32x16& p1, float alpha, float& l_reg, bf16x8& pa0, bf16x8& pa1, bf16x8& pa2, bf16x8& pa3) {
#pragma unroll
  for (int r = 0; r < 16; ++r) p1[r] = __builtin_amdgcn_exp2f(p1[r]);
  float ps = 0;
#pragma unroll
  for (int r = 0; r < 16; ++r) ps += p0[r];
#pragma unroll
  for (int r = 0; r < 16; ++r) ps += p1[r];
  { auto rr = __builtin_amdgcn_permlane32_swap(__float_as_uint(ps), __float_as_uint(ps), false, false);
    ps = __uint_as_float(rr[0]) + __uint_as_float(rr[1]); }
  l_reg = l_reg * alpha + ps;
#define PK4(P, BASE, OUT) do { unsigned a0 = cvt_pk_bf16(P[BASE + 0], P[BASE + 1]), a1 = cvt_pk_bf16(P[BASE + 2], P[BASE + 3]);   \
    unsigned b0 = cvt_pk_bf16(P[BASE + 4], P[BASE + 5]), b1 = cvt_pk_bf16(P[BASE + 6], P[BASE + 7]);                              \
    auto r0 = __builtin_amdgcn_permlane32_swap(a0, b0, false, false); auto r1 = __builtin_amdgcn_permlane32_swap(a1, b1, false, false); \
    u32x4 w = {r0[0], r1[0], r0[1], r1[1]}; OUT = *reinterpret_cast<bf16x8*>(&w); } while (0)
  PK4(p0, 0, pa0); PK4(p0, 8, pa1); PK4(p1, 0, pa2); PK4(p1, 8, pa3);
#undef PK4
}
__device__ __forceinline__ void qkt(f32x16& p0, f32x16& p1, const char* Ks, const bf16x8* qr, int r32, int hi) {
  p0 = f32x16{}; p1 = f32x16{};
#pragma unroll
  for (int d0 = 0; d0 < 12; ++d0) { int cb = (d0 * 16 + hi * 8) * 2;
    bf16x8 b0 = *reinterpret_cast<const bf16x8*>(Ks + KSWZ(r32, cb));
    bf16x8 b1 = *reinterpret_cast<const bf16x8*>(Ks + KSWZ(32 + r32, cb));
    p0 = __builtin_amdgcn_mfma_f32_32x32x16_bf16(b0, qr[d0], p0, 0, 0, 0);
    p1 = __builtin_amdgcn_mfma_f32_32x32x16_bf16(b1, qr[d0], p1, 0, 0, 0); }
}
__device__ __forceinline__ int v_st(int k, int c) { const int kk = (k & ~0xC) | ((k & 4) << 1) | ((k & 8) >> 1); return ((kk >> 3) * 4 + (c >> 5)) * 512 + ((kk & 7) * 32 + (c & 31)) * 2; }
__device__ __forceinline__ int v_rd_base(int lane) { return ((lane & 3) << 3) | (((lane >> 2) & 3) << 6) | (((lane >> 4) & 1) << 5) | (((lane >> 5) & 1) << 8); }
constexpr int v_rd_off(int d0, int ks, int half) { return d0 * 512 + ks * 4096 + half * 2048; }
template <int OFF> __device__ __forceinline__ s16x4 tr_read(int vb) {
  s16x4 r; asm volatile("ds_read_b64_tr_b16 %0, %1 offset:%2" : "=&v"(r) : "v"(vb), "i"(OFF) : "memory"); return r;
}
template <int D0> __device__ __forceinline__ void pv_one(f32x16& od, int vb, bf16x8 pa0, bf16x8 pa1, bf16x8 pa2, bf16x8 pa3) {
  const s16x4 l0 = tr_read<v_rd_off(D0, 0, 0)>(vb), h0 = tr_read<v_rd_off(D0, 0, 1)>(vb), l1 = tr_read<v_rd_off(D0, 1, 0)>(vb), h1 = tr_read<v_rd_off(D0, 1, 1)>(vb);
  const s16x4 l2 = tr_read<v_rd_off(D0, 2, 0)>(vb), h2 = tr_read<v_rd_off(D0, 2, 1)>(vb), l3 = tr_read<v_rd_off(D0, 3, 0)>(vb), h3 = tr_read<v_rd_off(D0, 3, 1)>(vb);
  asm volatile("s_waitcnt lgkmcnt(0)" ::: "memory"); SBAR();
#define PK(L, H) (bf16x8){L[0], L[1], L[2], L[3], H[0], H[1], H[2], H[3]}
  od = __builtin_amdgcn_mfma_f32_32x32x16_bf16(pa0, PK(l0, h0), od, 0, 0, 0);
  od = __builtin_amdgcn_mfma_f32_32x32x16_bf16(pa1, PK(l1, h1), od, 0, 0, 0);
  od = __builtin_amdgcn_mfma_f32_32x32x16_bf16(pa2, PK(l2, h2), od, 0, 0, 0);
  od = __builtin_amdgcn_mfma_f32_32x32x16_bf16(pa3, PK(l3, h3), od, 0, 0, 0);
#undef PK
}
__device__ __forceinline__ void pv_d0(f32x16* o, int vb, bf16x8 pa0, bf16x8 pa1, bf16x8 pa2, bf16x8 pa3) {
  pv_one<0>(o[0], vb, pa0, pa1, pa2, pa3); pv_one<1>(o[1], vb, pa0, pa1, pa2, pa3); pv_one<2>(o[2], vb, pa0, pa1, pa2, pa3); pv_one<3>(o[3], vb, pa0, pa1, pa2, pa3);
}
__device__ __forceinline__ void rope_pair(bf16x8& x1, bf16x8& x2, int pos, int hi) {
#pragma unroll
  for (int e = 0; e < 8; ++e) {
    const float inv = __builtin_amdgcn_exp2f(-(float)(hi * 8 + e) * 0.8304820237218407f);
    const float rev = (float)pos * inv * 0.15915494309189535f;
    const float cs = __builtin_amdgcn_cosf(rev), sn = __builtin_amdgcn_sinf(rev);
    const float a = bf2f((unsigned short)x1[e]), b = bf2f((unsigned short)x2[e]);
    x1[e] = (short)f2bf(a * cs - b * sn); x2[e] = (short)f2bf(b * cs + a * sn);
  }
}
__device__ __forceinline__ void attn_unit(const bf16_t* __restrict__ Qb, const bf16_t* __restrict__ Kh, const bf16_t* __restrict__ Vh, bf16_t* __restrict__ Ob, int seq, int rope_t0, char* lds, int wave) {
  const int lane = fresh_lane(), wid = wave, tid = wid * 64 + lane, r32 = lane & 31, hi = lane >> 5;
  char* V_lds = lds; char* K_lds = lds + 2 * SHM_V;
  float* wsf = (float*)(lds + 2 * SHM_V + 2 * SHM_K) + wid * 64; float* li_l = wsf; float* al_l = wsf + 32;
  float m_reg = -1e30f, l_reg = 0; f32x16 o[4] = {}; bf16x8 qr[12];
  const bf16_t* Qw = Qb + (long)(wid * QBLK + r32) * LDQ + hi * 8;
#pragma unroll
  for (int d0 = 0; d0 < 12; ++d0) qr[d0] = *reinterpret_cast<const bf16x8*>(Qw + d0 * 16);
  if (rope_t0 >= 0) { const int t = rope_t0 + wid * QBLK + r32; rope_pair(qr[8], qr[9], t >> 6, hi); rope_pair(qr[10], qr[11], t & 63, hi); }
  const int sr = tid >> 4, sc = (tid & 15) * 8, vst0 = v_st(sr, sc), vst1 = v_st(32 + sr, sc);
  const int kr0 = tid / 24, kc0 = tid % 24, kr1 = (tid + 512) / 24, kc1 = (tid + 512) % 24, kr2 = (tid + 1024) / 24, kc2 = (tid + 1024) % 24;
  const int vb0 = (int)(uintptr_t)V_lds + v_rd_base(lane);
  bf16x8 s_v0, s_v1, s_k0, s_k1, s_k2;
#define SLOAD(k0) do { s_v0 = *reinterpret_cast<const bf16x8*>(&Vh[(long)((k0) + sr) * LDV + sc]); s_v1 = *reinterpret_cast<const bf16x8*>(&Vh[(long)((k0) + 32 + sr) * LDV + sc]); \
    s_k0 = *reinterpret_cast<const bf16x8*>(&Kh[(long)((k0) + kr0) * LDK + kc0 * 8]); s_k1 = *reinterpret_cast<const bf16x8*>(&Kh[(long)((k0) + kr1) * LDK + kc1 * 8]); \
    s_k2 = *reinterpret_cast<const bf16x8*>(&Kh[(long)((k0) + kr2) * LDK + kc2 * 8]); } while (0)
#define SWRITE(b) do { *(bf16x8*)(V_lds + (b) * SHM_V + vst0) = s_v0; *(bf16x8*)(V_lds + (b) * SHM_V + vst1) = s_v1; \
    *(bf16x8*)(K_lds + (b) * SHM_K + KSWZ(kr0, kc0 * 16)) = s_k0; *(bf16x8*)(K_lds + (b) * SHM_K + KSWZ(kr1, kc1 * 16)) = s_k1; *(bf16x8*)(K_lds + (b) * SHM_K + KSWZ(kr2, kc2 * 16)) = s_k2; } while (0)
#define RESC(a) do { if (__any((a) < 1.f)) { if (hi == 0) al_l[r32] = (a); asm volatile("s_waitcnt lgkmcnt(0)" ::: "memory"); \
    _Pragma("unroll") for (int d = 0; d < 4; ++d) _Pragma("unroll") for (int r = 0; r < 16; ++r) o[d][r] *= al_l[crow(r, hi)]; } } while (0)
  f32x16 p0, p1; float mn, al; bf16x8 pa0, pa1, pa2, pa3; const int NT = seq / KVBLK;
  SLOAD(0); SWRITE(0); __syncthreads();
  for (int j = 0; j < NT; ++j) {
    const int buf = j & 1;
    if (j + 1 < NT) SLOAD((j + 1) * KVBLK);
    SBAR(); qkt(p0, p1, K_lds + buf * SHM_K, qr, r32, hi);
    partialSM(p0, p1, m_reg, mn, al);
    RESC(al);
    finishSM(p0, p1, al, l_reg, pa0, pa1, pa2, pa3); SBAR();
    pv_d0(o, vb0 + buf * SHM_V, pa0, pa1, pa2, pa3);
    if (j + 1 < NT) SWRITE(buf ^ 1);
    __syncthreads();
  }
  if (hi == 0) li_l[r32] = l_reg; asm volatile("s_waitcnt lgkmcnt(0)" ::: "memory");
  float rli[16];
#pragma unroll
  for (int r = 0; r < 16; ++r) rli[r] = __builtin_amdgcn_rcpf(li_l[crow(r, hi)]);
  bf16_t* Ow = Ob + (long)(wid * QBLK) * LDO;
#pragma unroll
  for (int r = 0; r < 16; ++r) { const int orow = crow(r, hi);
#pragma unroll
    for (int d0 = 0; d0 < 4; ++d0) Ow[(long)orow * LDO + d0 * 32 + r32] = (bf16_t)f2bf(o[d0][r] * rli[r]); }
  __syncthreads();
#undef SLOAD
#undef SWRITE
#undef RESC
}
}

constexpr int N_PHASES = 29;
#ifndef REP_MASK
#define REP_MASK 0
#endif
__device__ __forceinline__ GemmDesc mk_gemm(int kind, int epi, int perm, int total, int lda, int ldb, int hsA, int hsB, int ldc0, int ldc1, int layer, int li) {
    GemmDesc g; g.kind = kind; g.epi = epi; g.perm = perm; g.total = total; g.lda = lda; g.ldb = ldb; g.hsA = hsA; g.hsB = hsB; g.ldc0 = ldc0; g.ldc1 = ldc1; g.layer = layer; g.li = li; g.dry = 0; g.mr = 4;
    return g;
}
#define RUN_GEMM(g, GG, cc) gemm_phase(F.lds, g, F.ws, args.in[19], args.in[20], F.wave, GG, cc)
__device__ __forceinline__ void run_attention(Frame& F) {
    unsigned char* const wsp = opaque_ptr(F.ws);
    const bf16_t* QF = (const bf16_t*)(wsp + S_QF); const bf16_t* KF = (const bf16_t*)(wsp + S_KF); const bf16_t* VF = (const bf16_t*)(wsp + S_VF); bf16_t* O = (bf16_t*)(wsp + S_O);
    char* lds = (char*)F.lds;
    const int c = (int)blockIdx.x;
    const bool g256 = (F.G == 256);
    const int nu = g256 ? (c < 128 ? 1 : 2) : (384 - c + F.G - 1) / F.G;
    for (int k = 0; k < nu; ++k) {
        const int uidx = g256 ? (c < 128 ? c : 128 + 2 * (c - 128) + k) : c + k * F.G;
        const bool lat = uidx < 128;
        int tok0, krow0, h, seq, rt0;
        if (lat) { const int b = uidx >> 6, qb = uidx & 7; h = (uidx >> 3) & 7; tok0 = NP + b * SSEQ + qb * 256; krow0 = NP + b * SKV; seq = SKV; rt0 = qb * 256; }
        else { const int v = uidx - 128, b = v >> 3; h = v & 7; tok0 = b * PSEQ; krow0 = tok0; seq = PSEQ; rt0 = -1; }
        att::attn_unit(QF + (size_t)tok0 * 1536 + h * QKD, KF + (size_t)krow0 * 1536 + h * QKD, VF + (size_t)krow0 * 1024 + h * VD, O + (size_t)tok0 * 1024 + h * VD, seq, rt0, lds, F.wave);
    }
}

__global__ void __launch_bounds__(512, 2) mega_fwd(Args args) {
    extern __shared__ __attribute__((aligned(16))) unsigned char lds_raw[];
    Frame F;
    F.lds = (LAS unsigned char*)lds_raw; F.ws = args.ws; F.out = args.out;
    F.wave = __builtin_amdgcn_readfirstlane(threadIdx.x >> 6);
    F.G = gridDim.x; { const int bx = blockIdx.x; F.vcu = (F.G % 8 == 0) ? (bx % 8) * (F.G / 8) + bx / 8 : bx; }
    F.gw = F.vcu * 8 + F.wave; F.ngw = F.G * 8;
    volatile LAS unsigned* MISC = (volatile LAS unsigned*)(F.lds + MISC_OFF);
    for (int u = threadIdx.x; u < (LDS_BYTES - LDSCTL_OFF) / 4; u += 512) ((LAS unsigned*)(F.lds + LDSCTL_OFF))[u] = 0u;
    __syncthreads();
    unsigned* barw = (unsigned*)(F.ws + WS_CTL) + CW_BAR;
    XcdBarrier bar; bar.bar = barw; bar.x = 0; bar.st = nullptr;
    const int lo = args.ph_lo, hi = args.ph_hi;
    const bool multi = (hi - lo) > 1;
    if (multi) bar = xcd_barrier_post(barw, MISC + 8);
#define IN(k) (lo <= (k) && (k) < hi)
#define SEAM(k) do { if (IN(k) && IN((k) + 1)) xcd_barrier(bar); } while (0)
    int ph = 0;
    const int cx = (int)blockIdx.x;
#define PHASE(bit, body) do { if (IN(ph)) { const int nrep = 1 + ((REP_MASK >> (bit)) & 1); for (int rep = 0; rep < nrep; ++rep) { const int dry = rep; (void)dry; body; if (rep + 1 < nrep) xcd_barrier(bar); } } SEAM(ph); ++ph; } while (0)
    if (IN(ph)) { p0_prologue(F, args); } SEAM(ph); ++ph;
    PHASE(1, { { const GemmDesc g = mk_gemm(GK_WCOMB, EK_BF16, 1, 64, 1024, 256, 128 * 1024 * 2, 128 * 256 * 2, 1024, 1024, 0, 0); RUN_GEMM(g, F.G, cx); } pass_modulate(F, 0, 0); });
    for (int layer = 0; layer < 4; ++layer) {
        const int kind = layer % 3;
        if (layer > 0) PHASE(2, { pass_modulate(F, layer, 0); });
        if (kind == 0) {
            PHASE(3, { const GemmDesc g = mk_gemm(GK_F1, EK_BF16, 1, 8 * 48, DM, DM, 128 * DM * 2, 128 * DM * 2, 0, 0, layer, layer / 3); RUN_GEMM(g, F.G, cx); });
            PHASE(4, {
                if (F.G >= 128) {
                    if (cx >= 64) { GemmDesc g = mk_gemm(GK_F2P, EK_XRES, 0, 128, 512, 512, 128 * 512 * 2, 128 * 512 * 2, 0, 0, layer, 0); g.dry = dry; RUN_GEMM(g, F.G - 64, cx - 64); }
                    else { GemmDesc g = mk_gemm(GK_F2S, EK_XRES, 0, 64, 4096, 4096, 128 * 4096 * 2, 128 * 4096 * 2, 0, 0, layer, 0); g.dry = dry; RUN_GEMM(g, 64, cx); }
                } else {
                    { GemmDesc g = mk_gemm(GK_F2S, EK_XRES, 0, 64, 4096, 4096, 128 * 4096 * 2, 128 * 4096 * 2, 0, 0, layer, 0); g.dry = dry; RUN_GEMM(g, F.G, cx); }
                    { GemmDesc g = mk_gemm(GK_F2P, EK_XRES, 0, 128, 512, 512, 128 * 512 * 2, 128 * 512 * 2, 0, 0, layer, 0); g.dry = dry; RUN_GEMM(g, F.G, cx); }
                } });
        } else if (kind == 1) {
            PHASE(5, { pass_pool(F); });
            PHASE(6, { GemmDesc g = mk_gemm(GK_POOL, EK_XRES, 0, 64 * 4, DM, 256, 96 * DM * 2, 128 * 256 * 2, 0, 0, layer, 0); g.mr = 3; g.dry = dry; RUN_GEMM(g, F.G, cx); });
        } else {
            PHASE(7, { GemmDesc g = mk_gemm(GK_A1, EK_F32, 0, 64 * 6, DM, DM, 96 * DM * 2, 128 * DM * 2, NDOWN, NDOWN, layer, 0); g.mr = 3; RUN_GEMM(g, F.G, cx); });
            PHASE(8, { pass_mla_norm(F, args); });
            PHASE(9, { { const GemmDesc g = mk_gemm(GK_A3KV, EK_BF16, 1, 50 * 8, KVRANK, KVRANK, 128 * KVRANK * 2, 128 * KVRANK * 2, 1536, 1024, layer, 0); RUN_GEMM(g, F.G, cx); }
                       { GemmDesc g = mk_gemm(GK_A3Q, EK_BF16, 1, 64 * 6, QRANK, QRANK, 96 * QRANK * 2, 128 * QRANK * 2, 1536, 1536, layer, 0); g.mr = 3; RUN_GEMM(g, F.G, cx); } });
            PHASE(10, { run_attention(F); });
            PHASE(11, { GemmDesc g = mk_gemm(GK_A5, EK_XRES, 0, 64 * 4, DM, DM, 96 * DM * 2, 128 * DM * 2, 0, 0, layer, 0); g.mr = 3; g.dry = dry; RUN_GEMM(g, F.G, cx); });
        }
        PHASE(2, { pass_modulate(F, layer, 3); });
        PHASE(12, { const GemmDesc g = mk_gemm(GK_FFN1, EK_FFN1, 1, 50 * 22, DM, DM, 128 * DM * 2, DFF * DM * 2, 0, 0, layer, 0); RUN_GEMM(g, F.G, cx); });
        PHASE(13, { GemmDesc g = mk_gemm(GK_FFN2, EK_XRES, 0, 64 * 4, DFF, DFF, 96 * DFF * 2, 128 * DFF * 2, 0, 0, layer, 0); g.mr = 3; g.dry = dry; RUN_GEMM(g, F.G, cx); });
    }
    PHASE(14, { pass_final(F, args); });
#undef PHASE
#undef IN
#undef SEAM
}

extern "C" void kernel_launch(void* const* d_in, const int* in_sizes, int n_in, void* d_out, int out_size, void* d_ws, size_t ws_size, hipStream_t stream) {
    static int grid = 0;
    if (grid == 0) {
        const long want_out = (long)NTOK * DM + (long)NP * KVRANK + (long)NP * ROPE;
        if (n_in != 23 || in_sizes[0] != NP * DM || in_sizes[1] != NS * DM || (long)out_size != want_out || ws_size < WS_END) {
            fprintf(stderr, "kernel_launch: unexpected shapes: n_in %d in0 %d in1 %d out %d (want %ld) ws %zu (need %zu); nothing launched\n", n_in, n_in > 0 ? in_sizes[0] : -1, n_in > 1 ? in_sizes[1] : -1, out_size, want_out, ws_size, (size_t)WS_END);
            grid = -1; return; }
        int dev = 0, cus = 0;
        if (hipGetDevice(&dev) != hipSuccess || hipDeviceGetAttribute(&cus, hipDeviceAttributeMultiprocessorCount, dev) != hipSuccess) { fprintf(stderr, "kernel_launch: device query failed\n"); grid = -1; return; }
        if (hipFuncSetAttribute((const void*)mega_fwd, hipFuncAttributeMaxDynamicSharedMemorySize, LDS_BYTES) != hipSuccess) { fprintf(stderr, "kernel_launch: hipFuncSetAttribute failed\n"); grid = -1; return; }
        (void)hipGetLastError();
        grid = cus;
    }
    if (grid < 0) return;
    if (hipMemsetAsync((char*)d_ws + WS_CTL, 0, CTL_ZERO_BYTES, stream) != hipSuccess) { fprintf(stderr, "kernel_launch: memset failed\n"); return; }
    Args a{};
    for (int i = 0; i < 23; ++i) a.in[i] = (const float*)d_in[i];
    a.out = (float*)d_out; a.ws = (unsigned char*)d_ws;
#if MK_PER_PHASE
    for (int p = 0; p < N_PHASES; ++p) { a.ph_lo = p; a.ph_hi = p + 1; hipLaunchKernelGGL(mega_fwd, dim3(grid), dim3(512), LDS_BYTES, stream, a); }
#else
    a.ph_lo = 0; a.ph_hi = N_PHASES; hipLaunchKernelGGL(mega_fwd, dim3(grid), dim3(512), LDS_BYTES, stream, a);
#endif
    const hipError_t le = hipPeekAtLastError();
    if (le != hipSuccess) fprintf(stderr, "kernel_launch: launch failed: %s\n", hipGetErrorName(le));
}
```
